# Optimizing an MI355X kernel written in HIP

```python
import math
import jax, jax.numpy as jnp
from jax import lax
import numpy as np

D_MODEL = 1024
BATCH = 4
SEQ = 4096
DEPTH = 1

CHUNK = 64
QBLK = 128
N_HEADS_A = 4
HEAD_DIM_A = 64
V_DIM_A = 2 * HEAD_DIM_A
ATTN_WIDTH = N_HEADS_A * V_DIM_A
CONV_WIDTH = D_MODEL // 2
CONV_K = 31
N_REL_BUCKETS = 32
REL_MAX_DIST = 128
N_GROUPS = 8
EXPERTS_PER_GROUP = 8
N_EXPERTS = N_GROUPS * EXPERTS_PER_GROUP
TOP_K = 2
D_EXPERT = D_MODEL // 2
MOE_BLK = 128
EPS = 1e-6

Q_COLS = N_HEADS_A * 2 * HEAD_DIM_A
K_COLS = N_HEADS_A * 2 * HEAD_DIM_A
V_COLS = ATTN_WIDTH
GLU_COLS = 2 * CONV_WIDTH
GATE_COLS = 2 * D_MODEL
IN_COLS = Q_COLS + K_COLS + V_COLS + GLU_COLS + GATE_COLS

kernel_name = "hybrid_diffattn_conformer_hmoe_block"


def rmsnorm(x, g):
    xf = x.astype(jnp.float32)
    y = xf * lax.rsqrt(jnp.mean(xf * xf, axis=-1, keepdims=True) + EPS)
    return (y * g.astype(jnp.float32)).astype(x.dtype)


def layernorm(x, g, b):
    xf = x.astype(jnp.float32)
    mu = jnp.mean(xf, axis=-1, keepdims=True)
    xc = xf - mu
    y = xc * lax.rsqrt(jnp.mean(xc * xc, axis=-1, keepdims=True) + EPS)
    return (y * g.astype(jnp.float32) + b.astype(jnp.float32)).astype(x.dtype)


def rel_bucket(rel):
    nb = N_REL_BUCKETS // 2
    max_exact = nb // 2
    ret = jnp.where(rel > 0, nb, 0)
    n = jnp.abs(rel)
    nf = jnp.maximum(n, 1).astype(jnp.float32)
    large = max_exact + (jnp.log(nf / max_exact) / math.log(REL_MAX_DIST / max_exact)
                         * (nb - max_exact)).astype(jnp.int32)
    large = jnp.minimum(large, nb - 1)
    return ret + jnp.where(n < max_exact, n, large)


def diff_attention(q, k, v, lam, rel_bias):
    B, S = q.shape[0], q.shape[1]
    nq = S // QBLK
    scale = HEAD_DIM_A ** -0.5
    qb = q.reshape(B, nq, QBLK, N_HEADS_A, 2, HEAD_DIM_A).transpose(1, 0, 2, 3, 4, 5)
    kpos = jnp.arange(S)
    neg = jnp.finfo(jnp.float32).min

    def block(args):
        qblk, i = args
        qpos = i * QBLK + jnp.arange(QBLK)
        s = jnp.einsum('bqhmd,bkhmd->bhmqk', qblk, k).astype(jnp.float32) * scale
        bias = rel_bias.astype(jnp.float32)[rel_bucket(kpos[None, :] - qpos[:, None])]
        s = s + bias.transpose(2, 0, 1)[None, :, None]
        mask = (kpos[None, :] // CHUNK) <= (qpos[:, None] // CHUNK)
        s = jnp.where(mask[None, None, None], s, neg)
        p = jax.nn.softmax(s, axis=-1)
        a = p[:, :, 0] - lam * p[:, :, 1]
        return jnp.einsum('bhqk,bkhv->bqhv', a.astype(v.dtype), v)

    out = lax.map(block, (qb, jnp.arange(nq)))
    return out.transpose(1, 0, 2, 3, 4).reshape(B, S, N_HEADS_A, V_DIM_A)


def causal_depthwise_conv(u, w, b):
    C = u.shape[-1]
    y = lax.conv_general_dilated(u, w[:, None, :].astype(u.dtype), window_strides=(1,),
                                 padding=[(CONV_K - 1, 0)],
                                 dimension_numbers=('NWC', 'WIO', 'NWC'),
                                 feature_group_count=C)
    return y + b.astype(u.dtype)


def hier_moe(h, w_rg, b_rg, w_re, b_re, w_g, w_u, w_d):
    B, S, D = h.shape
    N = B * S
    hf = h.reshape(N, D)
    lg = (hf @ w_rg + b_rg).astype(jnp.float32)
    pg = jax.nn.softmax(lg, axis=-1)
    grp = jnp.argmax(lg, axis=-1)
    pg_top = jnp.take_along_axis(pg, grp[:, None], axis=-1)
    le = (hf @ w_re + b_re).astype(jnp.float32).reshape(N, N_GROUPS, EXPERTS_PER_GROUP)
    le_sel = jnp.take_along_axis(le, grp[:, None, None], axis=1)[:, 0]
    top_v, top_j = lax.top_k(le_sel, TOP_K)
    wts = pg_top * jax.nn.softmax(top_v, axis=-1)
    eid = grp[:, None] * EXPERTS_PER_GROUP + top_j
    A = N * TOP_K
    eid_f = eid.reshape(A)
    tok_f = jnp.repeat(jnp.arange(N), TOP_K)
    w_f = wts.reshape(A)
    order = jnp.argsort(eid_f)
    se, stok, sw = eid_f[order], tok_f[order], w_f[order]
    counts = jax.ops.segment_sum(jnp.ones((A,), jnp.int32), eid_f, num_segments=N_EXPERTS)
    starts = jnp.cumsum(counts) - counts
    pcounts = ((counts + MOE_BLK - 1) // MOE_BLK) * MOE_BLK
    pends = jnp.cumsum(pcounts)
    pstarts = pends - pcounts
    dest = pstarts[se] + (jnp.arange(A) - starts[se])
    P = A + N_EXPERTS * MOE_BLK
    nb = P // MOE_BLK
    row_tok = jnp.full((P,), N, jnp.int32).at[dest].set(stok)
    row_w = jnp.zeros((P,), jnp.float32).at[dest].set(sw)
    blk_e = jnp.minimum(jnp.searchsorted(pends, jnp.arange(nb) * MOE_BLK, side='right'),
                        N_EXPERTS - 1)
    xin = jnp.take(hf, row_tok, axis=0, mode='fill', fill_value=0).reshape(nb, MOE_BLK, D)

    def expert_block(args):
        xb, e = args
        return (jax.nn.silu(xb @ w_g[e]) * (xb @ w_u[e])) @ w_d[e]

    yb = lax.map(expert_block, (xin, blk_e)).reshape(P, D)
    yb = yb * row_w[:, None].astype(yb.dtype)
    out = jnp.zeros((N, D), hf.dtype).at[row_tok].add(yb, mode='drop')
    return out.reshape(B, S, D)


def setup_inputs(seed: int = 0) -> dict:
    key = jax.random.key(seed)
    ks = jax.random.split(key, 26)

    def nrm(k, shape, scale):
        return jax.random.normal(k, shape, jnp.float32) * scale

    L, D = DEPTH, D_MODEL
    return {
        "x": nrm(ks[0], (BATCH, SEQ, D), 1.0),
        "w_in": nrm(ks[1], (L, D, IN_COLS), D ** -0.5),
        "lambda_q1": nrm(ks[2], (L, HEAD_DIM_A), 0.1),
        "lambda_k1": nrm(ks[3], (L, HEAD_DIM_A), 0.1),
        "lambda_q2": nrm(ks[4], (L, HEAD_DIM_A), 0.1),
        "lambda_k2": nrm(ks[5], (L, HEAD_DIM_A), 0.1),
        "g_subln": 1.0 + nrm(ks[6], (L, V_DIM_A), 0.02),
        "rel_bias": nrm(ks[7], (N_REL_BUCKETS, N_HEADS_A), 0.2),
        "w_attn_up": nrm(ks[8], (L, ATTN_WIDTH, D), ATTN_WIDTH ** -0.5),
        "w_dw": nrm(ks[9], (L, CONV_K, CONV_WIDTH), CONV_K ** -0.5),
        "b_dw": nrm(ks[10], (L, CONV_WIDTH), 0.02),
        "g_conv_ln": 1.0 + nrm(ks[11], (L, CONV_WIDTH), 0.02),
        "b_conv_ln": nrm(ks[12], (L, CONV_WIDTH), 0.02),
        "w_conv_pw2": nrm(ks[13], (L, CONV_WIDTH, D), CONV_WIDTH ** -0.5),
        "b_conv_pw2": nrm(ks[14], (L, D), 0.02),
        "w_out": nrm(ks[15], (L, D, D), D ** -0.5),
        "g_mix": 1.0 + nrm(ks[16], (L, D), 0.02),
        "g_ffn": 1.0 + nrm(ks[17], (L, D), 0.02),
        "w_router_group": nrm(ks[18], (L, D, N_GROUPS), D ** -0.5),
        "b_router_group": nrm(ks[19], (L, N_GROUPS), 0.01),
        "w_router_expert": nrm(ks[20], (L, D, N_EXPERTS), D ** -0.5),
        "b_router_expert": nrm(ks[21], (L, N_EXPERTS), 0.01),
        "w_exp_gate": nrm(ks[22], (L, N_EXPERTS, D, D_EXPERT), D ** -0.5),
        "w_exp_up": nrm(ks[23], (L, N_EXPERTS, D, D_EXPERT), D ** -0.5),
        "w_exp_down": nrm(ks[24], (L, N_EXPERTS, D_EXPERT, D), D_EXPERT ** -0.5),
        "g_final": 1.0 + nrm(ks[25], (D,), 0.02),
    }


def reference(x, w_in, lambda_q1, lambda_k1, lambda_q2, lambda_k2, g_subln, rel_bias,
              w_attn_up, w_dw, b_dw, g_conv_ln, b_conv_ln, w_conv_pw2, b_conv_pw2, w_out,
              g_mix, g_ffn, w_router_group, b_router_group, w_router_expert, b_router_expert,
              w_exp_gate, w_exp_up, w_exp_down, g_final):
    B, S, D = x.shape
    o_q = 0
    o_k = o_q + Q_COLS
    o_v = o_k + K_COLS
    o_glu = o_v + V_COLS
    o_gate = o_glu + GLU_COLS
    for l in range(DEPTH):
        lam_init = 0.8 - 0.6 * math.exp(-0.3 * l)
        h = rmsnorm(x, g_mix[l])
        proj = h @ w_in[l]
        q = proj[..., o_q:o_k].reshape(B, S, N_HEADS_A, 2, HEAD_DIM_A)
        k = proj[..., o_k:o_v].reshape(B, S, N_HEADS_A, 2, HEAD_DIM_A)
        v = proj[..., o_v:o_glu].reshape(B, S, N_HEADS_A, V_DIM_A)
        glu = proj[..., o_glu:o_gate]
        gates = jax.nn.sigmoid(proj[..., o_gate:])
        lam = (jnp.exp(jnp.sum(lambda_q1[l].astype(jnp.float32) * lambda_k1[l].astype(jnp.float32)))
               - jnp.exp(jnp.sum(lambda_q2[l].astype(jnp.float32) * lambda_k2[l].astype(jnp.float32)))
               + lam_init)
        o = diff_attention(q, k, v, lam, rel_bias)
        o = rmsnorm(o, g_subln[l]) * (1.0 - lam_init)
        y_attn = o.reshape(B, S, ATTN_WIDTH) @ w_attn_up[l]
        u = glu[..., :CONV_WIDTH] * jax.nn.sigmoid(glu[..., CONV_WIDTH:])
        u = causal_depthwise_conv(u, w_dw[l], b_dw[l])
        u = jax.nn.silu(layernorm(u, g_conv_ln[l], b_conv_ln[l]))
        y_conv = u @ w_conv_pw2[l] + b_conv_pw2[l]
        merged = gates[..., :D] * y_attn + gates[..., D:] * y_conv
        x = x + merged @ w_out[l]
        x = x + hier_moe(rmsnorm(x, g_ffn[l]), w_router_group[l], b_router_group[l],
                         w_router_expert[l], b_router_expert[l],
                         w_exp_gate[l], w_exp_up[l], w_exp_down[l])
    return rmsnorm(x, g_final)
```

```cpp
#include <hip/hip_runtime.h>
#include <cstdio>
#include <cstdint>
#define MK_N_LAUNCHES 1
namespace pg8 {
#define PG8_LAS __attribute__((address_space(3)))
typedef unsigned short bf16_t;
typedef short bf16x8 __attribute__((ext_vector_type(8)));
typedef float f32x4 __attribute__((ext_vector_type(4)));
typedef unsigned u32x4 __attribute__((ext_vector_type(4)));
constexpr int BM = 256, BK = 64, HALF = 128, HTB = HALF * BK * 2  , STAGE_BYTES = 8 * HTB, NXCD = 8, WGM = 8;

__host__ __device__ __forceinline__ int lds_byte(int r, int c) { const int st = (r >> 4) * 2 + (c >> 5), rr = r & 15, cc = c & 31, ob = rr * 64 + cc * 2; return st * 1024 + (ob ^ (((ob >> 9) & 1) << 5)); }
__host__ __device__ __forceinline__ void stage_rc(int b, int& R, int& C) { const int st = b / 1024, sb = b % 1024, swz = sb ^ (((sb >> 9) & 1) << 5); R = (st >> 1) * 16 + swz / 64; C = (st & 1) * 32 + (swz % 64) / 2; }
__host__ __device__ __forceinline__ int perm32(int rho) { const int n = rho >> 4, i = rho & 15; return 8 * (i >> 2) + 4 * n + (i & 3); }

struct Unit { int pm, pn; };
struct Gemm { const bf16_t* A; const bf16_t* Bt; int M, N, K; };

struct StaticOrder {
    int nM, nN, nwg, G, c;
    __host__ __device__ void init(int M, int N, int G_, int c_) { nM = M / BM; nN = N / BM; nwg = nM * nN; G = G_; c = c_; }
    __host__ __device__ bool next(int i, Unit& u) const {
        const long L = (long)i * G + c; if (L >= nwg) return false;
        int wgid = (int)L; { const int q = nwg / NXCD, r = nwg % NXCD, xcd = wgid % NXCD, off = wgid / NXCD; wgid = (xcd < r ? xcd * (q + 1) : r * (q + 1) + (xcd - r) * q) + off; }
        const int nig = WGM * nN, gid = wgid / nig, fm = gid * WGM, gsz = (nM - fm) < WGM ? (nM - fm) : WGM;
        u.pm = fm + ((wgid % nig) % gsz); u.pn = (wgid % nig) / gsz; return true;
    }
    __device__ __forceinline__ void a_ready(const Unit&) const {}
    __device__ __forceinline__ void done(const Unit&) const {}
};

__device__ __forceinline__ unsigned cvt_pk_bf16(float lo, float hi) { unsigned r; asm volatile("v_cvt_pk_bf16_f32 %0, %1, %2" : "=v"(r) : "v"(lo), "v"(hi)); return r; }
typedef float f32x2 __attribute__((ext_vector_type(2)));
template <class Epi, class Sched, bool ALIGN_EPI = false, bool SP2 = false>
__device__ __forceinline__ void gemm_phase(PG8_LAS unsigned char* lds, const Gemm g, const Sched& S, const Epi& E) {
    const int tid = threadIdx.x, wid = __builtin_amdgcn_readfirstlane(tid >> 6), lane = tid & 63, wr = wid >> 2, wc = wid & 3, fr = lane & 15, fq = lane >> 4;
    const int K = g.K, nt = K / BK;
    unsigned voffA[2], voffB[2];
#pragma unroll
    for (int i = 0; i < 2; ++i) { int R, C; stage_rc(tid * 16 + i * 8192, R, C); const int Rb = Epi::PERM ? ((R & ~31) + perm32(R & 31)) : R;
        voffA[i] = (unsigned)(R * K + C) * 2u; voffB[i] = (unsigned)(Rb * K + C) * 2u; }
    const size_t kstep = (size_t)(BK * 2);
    const size_t hstep = (size_t)HALF * K * 2;
    const size_t tstep = 2 * hstep;
    const unsigned ldsw = (unsigned)wid * 1024u;
    const int aoff = lds_byte(wr * 64 + fr, fq * 8), boff = lds_byte(wc * 32 + fr, fq * 8);
#define PG8_SA(b, h) (((b) * 2 + (h)) * HTB)
#define PG8_SB(b, h) ((4 + (b) * 2 + (h)) * HTB)
#define PG8_STAGE(bufoff, gbase, voff) do { _Pragma("unroll") for (int _i = 0; _i < 2; ++_i) \
        __builtin_amdgcn_global_load_lds((const unsigned*)((const char*)(gbase) + (voff)[_i]), (PG8_LAS unsigned*)(lds + (bufoff) + ldsw + _i * 8192), 16, 0, 0); } while (0)
#define PG8_LDA(dst, b, h) do { _Pragma("unroll") for (int m = 0; m < 4; ++m) _Pragma("unroll") for (int k = 0; k < 2; ++k) dst[m][k] = *(const PG8_LAS bf16x8*)(lds + PG8_SA(b, h) + aoff + m * 2048 + k * 1024); } while (0)
#define PG8_LDB(dst, b, h) do { _Pragma("unroll") for (int n = 0; n < 2; ++n) _Pragma("unroll") for (int k = 0; k < 2; ++k) dst[n][k] = *(const PG8_LAS bf16x8*)(lds + PG8_SB(b, h) + boff + n * 2048 + k * 1024); } while (0)
#define PG8_MMA(ai, bj, At, Bt) do { __builtin_amdgcn_s_setprio(1); _Pragma("unroll") for (int m = 0; m < 4; ++m) _Pragma("unroll") for (int n = 0; n < 2; ++n) _Pragma("unroll") for (int k = 0; k < 2; ++k) \
        acc[ai][bj][m][n] = __builtin_amdgcn_mfma_f32_16x16x32_bf16(Bt[n][k], At[m][k], acc[ai][bj][m][n], 0, 0, 0); __builtin_amdgcn_s_setprio(0); } while (0)
#define PG8_WAIT_V(n) asm volatile("s_waitcnt vmcnt(" #n ")" ::: "memory")
#define PG8_WAIT_L(n) asm volatile("s_waitcnt lgkmcnt(" #n ")" ::: "memory")
#define PG8_BAR __builtin_amdgcn_s_barrier()
#define PG8_SCHED __builtin_amdgcn_sched_barrier(0)
    Unit cur, nxt; int ui = 0;
    if (!S.next(0, cur)) return;
    f32x4 acc[2][2][4][2];
#pragma unroll
    for (int a = 0; a < 2; ++a)
#pragma unroll
        for (int b = 0; b < 2; ++b)
#pragma unroll
            for (int m = 0; m < 4; ++m)
#pragma unroll
                for (int n = 0; n < 2; ++n) acc[a][b][m][n] = (f32x4){0.f, 0.f, 0.f, 0.f};
    bf16x8 At[4][2], B0[2][2], B1[2][2];
    const char* cA = (const char*)g.A + (size_t)cur.pm * tstep; const char* cB = (const char*)g.Bt + (size_t)cur.pn * tstep;
    S.a_ready(cur);
    if constexpr (SP2) {
        PG8_STAGE(PG8_SB(0, 0), cB, voffB); PG8_STAGE(PG8_SB(0, 1), cB + hstep, voffB); PG8_STAGE(PG8_SA(0, 0), cA, voffA); PG8_STAGE(PG8_SA(0, 1), cA + hstep, voffA);
        if (wr == 1) PG8_BAR;
        PG8_WAIT_V(2); PG8_BAR;
        PG8_STAGE(PG8_SB(1, 0), cB + kstep, voffB); PG8_STAGE(PG8_SA(1, 0), cA + kstep, voffA); PG8_STAGE(PG8_SB(1, 1), cB + hstep + kstep, voffB);
        PG8_WAIT_V(6); PG8_BAR;
    } else {
        PG8_STAGE(PG8_SB(0, 0), cB, voffB); PG8_STAGE(PG8_SA(0, 0), cA, voffA); PG8_STAGE(PG8_SB(0, 1), cB + hstep, voffB); PG8_STAGE(PG8_SA(0, 1), cA + hstep, voffA);
        if (wr == 1) PG8_BAR;
        PG8_WAIT_V(4); PG8_BAR;
        PG8_STAGE(PG8_SB(1, 0), cB + kstep, voffB); PG8_STAGE(PG8_SA(1, 0), cA + kstep, voffA); PG8_STAGE(PG8_SB(1, 1), cB + hstep + kstep, voffB);
        PG8_WAIT_V(6); PG8_BAR;
    }
    for (;;) {
        const bool has_next = S.next(ui + 1, nxt);
        const char* nA = has_next ? (const char*)g.A + (size_t)nxt.pm * tstep : cA; const char* nB = has_next ? (const char*)g.Bt + (size_t)nxt.pn * tstep : cB;
        for (int t = 0; t < nt; t += 2) {
            const bool last = (t == nt - 2);
            const char* a1 = cA + (size_t)(t + 1) * kstep;
            const char* a2 = last ? nA : cA + (size_t)(t + 2) * kstep; const char* b2 = last ? nB : cB + (size_t)(t + 2) * kstep;
            const char* a3 = a2 + kstep; const char* b3 = b2 + kstep;
            if (last && has_next) S.a_ready(nxt);
            if constexpr (SP2) {
            PG8_LDB(B0, 0, 0); PG8_LDB(B1, 0, 1); PG8_SCHED; PG8_LDA(At, 0, 0); PG8_STAGE(PG8_SA(1, 1), a1 + hstep, voffA);
            PG8_WAIT_V(8); PG8_WAIT_L(0); PG8_BAR; PG8_MMA(0, 0, At, B0); PG8_MMA(0, 1, At, B1); PG8_BAR; PG8_SCHED;
            PG8_LDA(At, 0, 1); PG8_STAGE(PG8_SB(0, 0), b2, voffB); PG8_STAGE(PG8_SB(0, 1), b2 + hstep, voffB); PG8_STAGE(PG8_SA(0, 0), a2, voffA);
            PG8_WAIT_V(8); PG8_WAIT_L(0); PG8_BAR; PG8_MMA(1, 0, At, B0); PG8_MMA(1, 1, At, B1); PG8_BAR; PG8_SCHED;
            PG8_LDB(B0, 1, 0); PG8_LDB(B1, 1, 1); PG8_SCHED; PG8_LDA(At, 1, 0); PG8_STAGE(PG8_SA(0, 1), a2 + hstep, voffA);
            PG8_WAIT_V(8); PG8_WAIT_L(0); PG8_BAR; PG8_MMA(0, 0, At, B0); PG8_MMA(0, 1, At, B1); PG8_BAR; PG8_SCHED;
            PG8_LDA(At, 1, 1); PG8_STAGE(PG8_SB(1, 0), b3, voffB); PG8_STAGE(PG8_SB(1, 1), b3 + hstep, voffB); PG8_STAGE(PG8_SA(1, 0), a3, voffA);
            PG8_WAIT_V(8); PG8_WAIT_L(0); PG8_BAR; PG8_MMA(1, 0, At, B0); PG8_MMA(1, 1, At, B1); PG8_BAR; PG8_SCHED;
            } else {
            PG8_LDB(B0, 0, 0); PG8_SCHED; PG8_LDA(At, 0, 0); PG8_STAGE(PG8_SA(1, 1), a1 + hstep, voffA);
            PG8_WAIT_L(8); PG8_BAR; PG8_WAIT_L(0); PG8_MMA(0, 0, At, B0); PG8_BAR; PG8_SCHED;
            PG8_LDB(B1, 0, 1); PG8_STAGE(PG8_SB(0, 0), b2, voffB);
            PG8_BAR; PG8_WAIT_L(0); PG8_MMA(0, 1, At, B1); PG8_BAR;
            PG8_LDA(At, 0, 1); PG8_STAGE(PG8_SA(0, 0), a2, voffA);
            PG8_BAR; PG8_WAIT_L(0); PG8_MMA(1, 0, At, B0); PG8_BAR; PG8_SCHED;
            PG8_STAGE(PG8_SB(0, 1), b2 + hstep, voffB);
            PG8_WAIT_V(6); PG8_BAR; PG8_MMA(1, 1, At, B1); PG8_BAR;
            PG8_LDB(B0, 1, 0); PG8_SCHED; PG8_LDA(At, 1, 0); PG8_STAGE(PG8_SA(0, 1), a2 + hstep, voffA);
            PG8_WAIT_L(8); PG8_BAR; PG8_WAIT_L(0); PG8_MMA(0, 0, At, B0); PG8_BAR; PG8_SCHED;
            PG8_LDB(B1, 1, 1); PG8_STAGE(PG8_SB(1, 0), b3, voffB);
            PG8_BAR; PG8_WAIT_L(0); PG8_MMA(0, 1, At, B1); PG8_BAR;
            PG8_LDA(At, 1, 1); PG8_STAGE(PG8_SA(1, 0), a3, voffA);
            PG8_BAR; PG8_WAIT_L(0); PG8_MMA(1, 0, At, B0); PG8_BAR; PG8_SCHED;
            PG8_STAGE(PG8_SB(1, 1), b3 + hstep, voffB);
            PG8_WAIT_V(6); PG8_BAR; PG8_MMA(1, 1, At, B1); PG8_BAR;
            }
        }
        if constexpr (ALIGN_EPI) { if (wr == 0) PG8_BAR; }
        if constexpr (!Epi::AFTER_DRAIN) { E(acc, cur, wr, wc, fr, fq); S.done(cur); }
        if (!has_next) break;
#pragma unroll
        for (int a = 0; a < 2; ++a)
#pragma unroll
            for (int b = 0; b < 2; ++b)
#pragma unroll
                for (int m = 0; m < 4; ++m)
#pragma unroll
                    for (int n = 0; n < 2; ++n) acc[a][b][m][n] = (f32x4){0.f, 0.f, 0.f, 0.f};
        cur = nxt; cA = nA; cB = nB; ++ui;
        if constexpr (ALIGN_EPI) { if (wr == 1) PG8_BAR; }
    }
    PG8_WAIT_V(0);
    if constexpr (!ALIGN_EPI) { if (wr == 0) PG8_BAR; }
    PG8_BAR;
    if constexpr (Epi::AFTER_DRAIN) { E.fused(acc, cur, wr, wc, fr, fq, lds, wid, lane); S.done(cur); }
#undef PG8_SA
#undef PG8_SB
#undef PG8_STAGE
#undef PG8_LDA
#undef PG8_LDB
#undef PG8_MMA
#undef PG8_WAIT_V
#undef PG8_WAIT_L
#undef PG8_BAR
#undef PG8_SCHED
}
}
constexpr int NWAVES = 8;
constexpr int NB = 4, SEQ = 4096, D = 1024, M = NB * SEQ;
constexpr int NH = 4, VD = 128, AW = 512, CWID = 512, CK = 31;
constexpr int NCOL = 4608;
constexpr int NE = 64, DE = 512;
constexpr float EPS = 1e-6f;
constexpr float LOG2E = 1.4426950408889634f;
constexpr float QSCALE = 0.125f * LOG2E;
constexpr int MAXTILES = 192;
constexpr int NPHASE = 10;

constexpr size_t MiB = 1u << 20;
constexpr size_t WS_CTL = 0, CTL_ZERO_BYTES = 1 * MiB;
constexpr size_t WS_WRF = 1 * MiB;
constexpr size_t WS_TOKINFO = 2 * MiB;
constexpr size_t WS_TOKSLOT = 2 * MiB + 512 * 1024;
constexpr size_t WS_ROWW = 2 * MiB + 768 * 1024;
constexpr size_t WS_WIN = 4 * MiB;
constexpr size_t WS_WMIX = 13 * MiB;
constexpr size_t WS_WOUT = 15 * MiB;
constexpr size_t WS_WGU = 17 * MiB;
constexpr size_t WS_WD = 145 * MiB;
constexpr size_t WS_B = 209 * MiB;
constexpr size_t WS_XN = WS_B + 0 * MiB;
constexpr size_t WS_Q = WS_B + 32 * MiB;
constexpr size_t WS_K = WS_B + 48 * MiB;
constexpr size_t WS_V = WS_B + 64 * MiB;
constexpr size_t WS_U = WS_B + 80 * MiB;
constexpr size_t WS_G = WS_B + 96 * MiB;
constexpr size_t WS_AO = WS_B + 160 * MiB;
constexpr size_t WS_UC = WS_B + 176 * MiB;
constexpr size_t WS_MG = WS_B + 192 * MiB;
constexpr size_t WS_T = WS_B + 0 * MiB;
constexpr size_t WS_XG = WS_B + 0 * MiB;
constexpr size_t WS_ACT = WS_B + 96 * MiB;
constexpr size_t WS_Y = WS_B + 144 * MiB;
constexpr size_t WS_END = WS_B + 240 * MiB;
constexpr int CW_BAR = 4096;
constexpr int CW_GCNT = 8192;

constexpr int RING_OFF = 0, RING_BYTES = 131072;
constexpr int LDSCTL_OFF = RING_BYTES;
constexpr int ATT_TAB_OFF = RING_BYTES + 512;
constexpr int MOE_TAB_OFF = RING_BYTES + 4096;
constexpr int LDS_BYTES = 147456;

#define GAS __attribute__((address_space(1)))
#define LAS __attribute__((address_space(3)))
typedef unsigned short bf16;
typedef unsigned v4u __attribute__((ext_vector_type(4)));
typedef unsigned v2u __attribute__((ext_vector_type(2)));
typedef float f32x4 __attribute__((ext_vector_type(4)));
typedef float f32x16 __attribute__((ext_vector_type(16)));
typedef short bf16x8 __attribute__((ext_vector_type(8)));
typedef short s16x4 __attribute__((ext_vector_type(4)));
typedef GAS unsigned gu32;
#define RLX_AGENT __ATOMIC_RELAXED, __HIP_MEMORY_SCOPE_AGENT
#define LDS_WAIT() asm volatile("s_waitcnt lgkmcnt(0)" ::: "memory")
#define VM_WAIT() asm volatile("s_waitcnt vmcnt(0)" ::: "memory")
typedef float f32x2_t __attribute__((ext_vector_type(2)));
typedef __bf16 bf16x2_t __attribute__((ext_vector_type(2)));
__device__ __forceinline__ unsigned pk2(float lo, float hi) { f32x2_t v = {lo, hi}; bf16x2_t b = __builtin_convertvector(v, bf16x2_t); return __builtin_bit_cast(unsigned, b); }
__device__ __forceinline__ float bf2f(unsigned short h) { return __uint_as_float((unsigned)h << 16); }
__device__ __forceinline__ float bflo(unsigned w) { return __uint_as_float(w << 16); }
__device__ __forceinline__ float bfhi(unsigned w) { return __uint_as_float(w & 0xffff0000u); }
__device__ __forceinline__ float sigmoidf_(float x) { return __builtin_amdgcn_rcpf(1.f + __expf(-x)); }
__device__ __forceinline__ float wave_sum(float v) {
#pragma unroll
    for (int o = 1; o < 64; o <<= 1) v += __shfl_xor(v, o);
    return v;
}
__device__ __forceinline__ float xhalf_max(float a) { auto rr = __builtin_amdgcn_permlane32_swap(__float_as_uint(a), __float_as_uint(a), false, false); return fmaxf(__uint_as_float(rr[0]), __uint_as_float(rr[1])); }
__device__ __forceinline__ float xhalf_sum(float a) { auto rr = __builtin_amdgcn_permlane32_swap(__float_as_uint(a), __float_as_uint(a), false, false); return __uint_as_float(rr[0]) + __uint_as_float(rr[1]); }
__device__ __forceinline__ int crow(int r, int hi) { return (r & 3) + 8 * (r >> 2) + 4 * hi; }

#define XB_TMO      128
#define XB_XCNT(j)  (256  + 64 * (j))
#define XB_XSUB(j)  (1280 + 64 * (j))
#define XB_XGEN(j)  (2304 + 64 * (j))
#define XB_TOP      3328
#define XB_TOPGEN   3392
#define XCD_BAR_WORDS 3456
#define XB_SPIN_CAP (1u << 18)

__device__ __forceinline__ unsigned xb_ld(unsigned* p)              { return __hip_atomic_load(p, __ATOMIC_RELAXED, __HIP_MEMORY_SCOPE_AGENT); }
__device__ __forceinline__ unsigned xb_add(unsigned* p, unsigned v) { return __hip_atomic_fetch_add(p, v, __ATOMIC_RELAXED, __HIP_MEMORY_SCOPE_AGENT); }
__device__ __forceinline__ unsigned xb_xcc_id() { return (unsigned)__builtin_amdgcn_s_getreg((3 << 11) | 20) & 0xFu; }
#define XB_SPIN(cond, bar) do { unsigned _sp = 0; while (cond) { __builtin_amdgcn_s_sleep(1); \
    if ((++_sp & 255u) == 0u) { if (xb_ld(&(bar)[XB_TMO])) break; if (_sp > XB_SPIN_CAP) { atomicAdd(&(bar)[XB_TMO], 1u); break; } } } } while (0)

struct XcdBarrier {
    unsigned* bar; unsigned x;
    volatile LAS unsigned* st;
};

__device__ __forceinline__ XcdBarrier xcd_barrier_post(unsigned* bar, volatile LAS unsigned* st) {
    XcdBarrier b; b.bar = bar; b.x = xb_xcc_id(); b.st = st;
    if (threadIdx.x == 0) (void)xb_add(&bar[XB_XCNT(b.x)], 1u);
    return b;
}
__device__ __forceinline__ void xcd_barrier_complete(unsigned* bar, unsigned x, unsigned& nloc, unsigned& nx) {
    const unsigned G = gridDim.x * gridDim.y * gridDim.z;
    unsigned sum, cnt, mine, sp = 0u;
    for (;;) {
        sum = 0u; cnt = 0u; mine = 0u;
#pragma unroll
        for (unsigned j = 0; j < 16; ++j) { const unsigned c = xb_ld(&bar[XB_XCNT(j)]); sum += c; cnt += (c > 0u) ? 1u : 0u; mine = (j == x) ? c : mine; }
        if (sum == G) break;
        __builtin_amdgcn_s_sleep(1);
        if ((++sp & 255u) == 0u) { if (xb_ld(&bar[XB_TMO])) break; if (sp > XB_SPIN_CAP) { atomicAdd(&bar[XB_TMO], 1u); break; } }
    }
    nloc = mine > 0u ? mine : 1u; nx = cnt > 0u ? cnt : 1u;
}

__device__ __forceinline__ void xcd_barrier(const XcdBarrier& b) {
    asm volatile("s_waitcnt vmcnt(0)" ::: "memory");
    __syncthreads();
    if (threadIdx.x == 0) {
        unsigned* bar = b.bar;
        __builtin_amdgcn_s_waitcnt(0);
        unsigned nloc = b.st[0], nx = b.st[1];
        if (nloc == 0u) { xcd_barrier_complete(bar, b.x, nloc, nx); b.st[0] = nloc; b.st[1] = nx; }
        const unsigned old = xb_add(&bar[XB_XSUB(b.x)], 1u);
        const unsigned gen = old / nloc;
        if (old + 1u == (gen + 1u) * nloc) {
            __builtin_amdgcn_fence(__ATOMIC_RELEASE, "agent");
            asm volatile("s_waitcnt vmcnt(0)" ::: "memory");
            const unsigned og = xb_add(&bar[XB_TOP], 1u);
            const unsigned tg = og / nx;
            if (og + 1u == (tg + 1u) * nx) xb_add(&bar[XB_TOPGEN], 1u);
            else XB_SPIN(xb_ld(&bar[XB_TOPGEN]) == tg, bar);
            __builtin_amdgcn_fence(__ATOMIC_ACQUIRE, "agent");
            xb_add(&bar[XB_XGEN(b.x)], 1u);
            asm volatile("s_waitcnt vmcnt(0)" ::: "memory");
        } else {
            XB_SPIN(xb_ld(&bar[XB_XGEN(b.x)]) == gen, bar);
            __builtin_amdgcn_fence(__ATOMIC_ACQUIRE, "agent");
            asm volatile("s_waitcnt vmcnt(0)" ::: "memory");
        }
    }
    __syncthreads();
}

struct Frame {
    LAS unsigned char* lds;
    gu32* ctl;
    int tid, lane, wave;
    int vcu, G;
    const float *x, *w_in, *lq1, *lk1, *lq2, *lk2, *gsub, *relb, *w_au, *w_dw, *b_dw, *g_cln, *b_cln, *w_pw, *b_pw, *w_out, *g_mix, *g_ffn,
                *w_rg, *b_rg, *w_re, *b_re, *w_eg, *w_eu, *w_ed, *g_fin;
    float* out;
    bf16 *Win_t, *Wmix_t, *Wout_t, *Wgu_t, *Wd_t;
    bf16 *XN, *Qb, *Kb, *Vb, *U, *Gt, *AO, *UC, *MG, *XG, *ACT, *Y;
    float *T, *Wrf, *roww;
    int *tokinfo, *tokslot;
};

__device__ __forceinline__ int win_src_col(int pc) {
    if (pc < 1536 || pc >= 2560) return pc;
    const int t = (pc - 1536) >> 8, w = (pc - 1536) & 255, bj = w >> 7, i = w & 127;
    return 1536 + bj * 512 + t * 128 + i;
}
__device__ __forceinline__ void tr_tile(const float* src, int ldn, int k0, int c0, bf16* dst, int K, size_t r0, LAS unsigned* scr, int lane) {
    const int n4 = (lane & 15) * 4, kr = lane >> 4;
    f32x4 a[8], b[8];
#pragma unroll
    for (int i = 0; i < 8; ++i) { const int kp = 4 * i + kr;
        a[i] = *(const GAS f32x4*)(src + (size_t)(k0 + 2 * kp) * ldn + c0 + n4);
        b[i] = *(const GAS f32x4*)(src + (size_t)(k0 + 2 * kp + 1) * ldn + c0 + n4); }
#pragma unroll
    for (int i = 0; i < 8; ++i) { const int kp = 4 * i + kr;
        scr[(n4 + 0) * 33 + kp] = pk2(a[i].x, b[i].x); scr[(n4 + 1) * 33 + kp] = pk2(a[i].y, b[i].y);
        scr[(n4 + 2) * 33 + kp] = pk2(a[i].z, b[i].z); scr[(n4 + 3) * 33 + kp] = pk2(a[i].w, b[i].w); }
    LDS_WAIT(); asm volatile("" ::: "memory");
#pragma unroll
    for (int jj = 0; jj < 8; ++jj) { const int n = (lane >> 3) + 8 * jj, ch = lane & 7;
        v4u o; o.x = scr[n * 33 + ch * 4 + 0]; o.y = scr[n * 33 + ch * 4 + 1]; o.z = scr[n * 33 + ch * 4 + 2]; o.w = scr[n * 33 + ch * 4 + 3];
        *(GAS v4u*)(dst + (r0 + n) * (size_t)K + k0 + ch * 8) = o; }
    LDS_WAIT(); asm volatile("" ::: "memory");
}
__device__ __forceinline__ void p0_prologue(Frame& F) {
    LAS unsigned* scr = (LAS unsigned*)(F.lds + RING_OFF + F.wave * 8704);
    const int gw = F.vcu * NWAVES + F.wave, NGW = F.G * NWAVES, lane = F.lane;
    constexpr int I_IN = 16 * 72, I_AU = 8 * 16, I_PW = 8 * 16, I_OUT = 16 * 16, I_EXP = 384;
    constexpr int NITEMS = I_IN + I_AU + I_PW + I_OUT + NE * I_EXP;
    for (int it = gw; it < NITEMS; it += NGW) {
        int r = it;
        if (r < I_IN) { const int kt = r / 72, rt = r % 72; tr_tile(F.w_in, NCOL, kt * 64, win_src_col(rt * 64), F.Win_t, 1024, (size_t)rt * 64, scr, lane); continue; } r -= I_IN;
        if (r < I_AU) { const int kt = r / 16, rt = r % 16; tr_tile(F.w_au, 1024, kt * 64, rt * 64, F.Wmix_t, 512, (size_t)rt * 64, scr, lane); continue; } r -= I_AU;
        if (r < I_PW) { const int kt = r / 16, rt = r % 16; tr_tile(F.w_pw, 1024, kt * 64, rt * 64, F.Wmix_t, 512, (size_t)1024 + rt * 64, scr, lane); continue; } r -= I_PW;
        if (r < I_OUT) { const int kt = r / 16, rt = r % 16; tr_tile(F.w_out, 1024, kt * 64, rt * 64, F.Wout_t, 1024, (size_t)rt * 64, scr, lane); continue; } r -= I_OUT;
        const int e = r / I_EXP; r -= e * I_EXP;
        if (r < 256) {
            const int bj = r >> 7, q = r & 127, kt = q >> 3, ct = q & 7, c0 = ct * 64;
            const float* src = (bj ? F.w_eu : F.w_eg) + (size_t)e * 1024 * 512;
            tr_tile(src, 512, kt * 64, c0, F.Wgu_t, 1024, (size_t)e * 1024 + (c0 >> 7) * 256 + bj * 128 + (c0 & 127), scr, lane);
        } else {
            const int q = r - 256, kt = q >> 4, ct = q & 15;
            tr_tile(F.w_ed + (size_t)e * 512 * 1024, 1024, kt * 64, ct * 64, F.Wd_t, 512, (size_t)e * 1024 + ct * 64, scr, lane);
        }
    }
    for (int m = gw; m < M; m += NGW) {
        const GAS f32x4* xr = (const GAS f32x4*)(F.x + (size_t)m * D) + lane; const GAS f32x4* gr = (const GAS f32x4*)F.g_mix + lane;
        f32x4 v[4]; float s = 0.f;
#pragma unroll
        for (int j = 0; j < 4; ++j) { v[j] = xr[64 * j]; s += (v[j].x * v[j].x + v[j].y * v[j].y) + (v[j].z * v[j].z + v[j].w * v[j].w); }
        const float rs = rsqrtf(wave_sum(s) * (1.f / D) + EPS);
        GAS v2u* o8 = (GAS v2u*)(F.XN + (size_t)m * D) + lane;
#pragma unroll
        for (int j = 0; j < 4; ++j) { const f32x4 g = gr[64 * j]; v2u o; o.x = pk2(v[j].x * rs * g.x, v[j].y * rs * g.y); o.y = pk2(v[j].z * rs * g.z, v[j].w * rs * g.w); o8[64 * j] = o; }
    }
    for (int i = F.vcu * 512 + F.tid; i < 64 * 5 * 64 * 4; i += F.G * 512) {
        const int j = i & 3, l = (i >> 2) & 63, q = i >> 8, ct = q % 5, kc = q / 5;
        const int k = kc * 16 + 4 * (l >> 4) + j, c = ct * 16 + (l & 15);
        float wv = 0.f; if (c < 8) wv = F.w_rg[k * 8 + c]; else if (c < 72) wv = F.w_re[k * 64 + (c - 8)];
        F.Wrf[i] = wv * F.g_ffn[k];
    }
}

using pg8::Unit;
struct EpiProj {
    static constexpr bool PERM = true, AFTER_DRAIN = false;
    bf16 *Q, *K, *V, *U, *G;
    __device__ __forceinline__ void operator()(const f32x4 (&acc)[2][2][4][2], const Unit& u, int wr, int wc, int fr, int fq) const {
        int row0 = u.pm * 256 + wr * 64 + fr; const int pn = u.pn;
        asm volatile("" : "+v"(row0), "+v"(fq));
        if (pn < 6) {
            bf16* base = Q + (size_t)(pn >> 1) * ((size_t)M * 512); const float sc = pn < 2 ? QSCALE : 1.f;
            const int col0 = (pn & 1) * 256 + wc * 32 + 8 * fq;
#pragma unroll
            for (int ai = 0; ai < 2; ++ai)
#pragma unroll
                for (int m = 0; m < 4; ++m) { bf16* rowp = base + (size_t)(row0 + ai * 128 + m * 16) * 512 + col0;
#pragma unroll
                    for (int bj = 0; bj < 2; ++bj) { const f32x4 v0 = acc[ai][bj][m][0] * sc, v1 = acc[ai][bj][m][1] * sc; v4u w;
                        w.x = pk2(v0[0], v0[1]); w.y = pk2(v0[2], v0[3]); w.z = pk2(v1[0], v1[1]); w.w = pk2(v1[2], v1[3]);
                        *(v4u*)(rowp + bj * 128) = w; } }
        } else if (pn < 10) {
            const int col0 = (pn - 6) * 128 + wc * 32 + 8 * fq;
#pragma unroll
            for (int ai = 0; ai < 2; ++ai)
#pragma unroll
                for (int m = 0; m < 4; ++m) { bf16* rowp = U + (size_t)(row0 + ai * 128 + m * 16) * 512 + col0;
                    const f32x4 a0 = acc[ai][0][m][0], a1 = acc[ai][0][m][1], b0 = acc[ai][1][m][0], b1 = acc[ai][1][m][1]; v4u w;
                    w.x = pk2(a0[0] * sigmoidf_(b0[0]), a0[1] * sigmoidf_(b0[1])); w.y = pk2(a0[2] * sigmoidf_(b0[2]), a0[3] * sigmoidf_(b0[3]));
                    w.z = pk2(a1[0] * sigmoidf_(b1[0]), a1[1] * sigmoidf_(b1[1])); w.w = pk2(a1[2] * sigmoidf_(b1[2]), a1[3] * sigmoidf_(b1[3]));
                    *(v4u*)rowp = w; }
        } else {
            const int col0 = (pn - 10) * 256 + wc * 32 + 8 * fq;
#pragma unroll
            for (int ai = 0; ai < 2; ++ai)
#pragma unroll
                for (int m = 0; m < 4; ++m) { bf16* rowp = G + (size_t)(row0 + ai * 128 + m * 16) * 2048 + col0;
#pragma unroll
                    for (int bj = 0; bj < 2; ++bj) { const f32x4 v0 = acc[ai][bj][m][0], v1 = acc[ai][bj][m][1]; v4u w;
                        w.x = pk2(sigmoidf_(v0[0]), sigmoidf_(v0[1])); w.y = pk2(sigmoidf_(v0[2]), sigmoidf_(v0[3]));
                        w.z = pk2(sigmoidf_(v1[0]), sigmoidf_(v1[1])); w.w = pk2(sigmoidf_(v1[2]), sigmoidf_(v1[3]));
                        *(v4u*)(rowp + bj * 128) = w; } }
        }
    }
};
struct EpiMerge {
    static constexpr bool PERM = true, AFTER_DRAIN = false;
    const bf16* G; const float* bpw; float* Tw; bf16* MG;
    __device__ __forceinline__ void operator()(const f32x4 (&acc)[2][2][4][2], const Unit& u, int wr, int wc, int fr, int fq) const {
        const bool sub = u.pm >= 64; const int pm = u.pm & 63, pn = u.pn & 3;
        int row0 = pm * 256 + wr * 64 + fr, col0 = pn * 256 + wc * 32 + 8 * fq, tix = threadIdx.x;
        asm volatile("" : "+v"(row0), "+v"(col0), "+v"(tix));
#ifdef DBG_SIMPLE_MERGE
#ifdef DBG_DELAY
        if (!sub) { const unsigned long long t0_ = __builtin_amdgcn_s_memrealtime(); while (__builtin_amdgcn_s_memrealtime() - t0_ < 2000ull) __builtin_amdgcn_s_sleep(4); }
#endif
#ifdef DBG_GLOAD
        float gsum = 0.f;
        if (!sub) {
#pragma unroll
            for (int ai = 0; ai < 2; ++ai)
#pragma unroll
                for (int m = 0; m < 4; ++m) { const bf16* gp = G + (size_t)(row0 + ai * 128 + m * 16) * 2048 + col0; const v4u g = *(const v4u*)gp; gsum += bflo(g.x) + bflo(g.w); asm volatile("" ::: "memory"); }
            if (gsum == 12345.678f) MG[0] = 1;
        }
#endif
        if (sub) {
#pragma unroll
            for (int ai = 0; ai < 2; ++ai)
#pragma unroll
                for (int m = 0; m < 4; ++m) { bf16* op = MG + (size_t)(row0 + ai * 128 + m * 16) * 1024 + col0;
#pragma unroll
                    for (int bj = 0; bj < 2; ++bj) { const f32x4 v0 = acc[ai][bj][m][0], v1 = acc[ai][bj][m][1]; v4u w;
                        w.x = pk2(v0[0], v0[1]); w.y = pk2(v0[2], v0[3]); w.z = pk2(v1[0], v1[1]); w.w = pk2(v1[2], v1[3]);
                        *(v4u*)(op + bj * 128) = w; } }
        }
        return;
#endif
        f32x4* tp = (f32x4*)Tw + (size_t)tix * 4;
        if (!sub) {
#pragma unroll
            for (int ai = 0; ai < 2; ++ai)
#pragma unroll
                for (int m = 0; m < 4; ++m) { const bf16* gp = G + (size_t)(row0 + ai * 128 + m * 16) * 2048 + col0;
#pragma unroll
                    for (int bj = 0; bj < 2; ++bj) { const v4u g = *(const v4u*)(gp + bj * 128); const f32x4 v0 = acc[ai][bj][m][0], v1 = acc[ai][bj][m][1];
                        f32x4* tg = tp + (size_t)(ai * 4 + m) * 2048 + bj * 2;
#ifndef DBG_NO_TSTORE
                        tg[0] = (f32x4){v0[0] * bflo(g.x), v0[1] * bfhi(g.x), v0[2] * bflo(g.y), v0[3] * bfhi(g.y)};
                        tg[1] = (f32x4){v1[0] * bflo(g.z), v1[1] * bfhi(g.z), v1[2] * bflo(g.w), v1[3] * bfhi(g.w)};
#else
                        if (v0[0] * bflo(g.x) + v1[3] * bfhi(g.w) == 12345.678f) tg[0] = v0;
#endif
                        }
                    asm volatile("" ::: "memory"); }
        } else {
            f32x4 bv[2][2];
#pragma unroll
            for (int bj = 0; bj < 2; ++bj) { bv[bj][0] = *(const f32x4*)(bpw + col0 + bj * 128); bv[bj][1] = *(const f32x4*)(bpw + col0 + bj * 128 + 4); }
#pragma unroll
            for (int ai = 0; ai < 2; ++ai)
#pragma unroll
                for (int m = 0; m < 4; ++m) { const size_t rr = (size_t)(row0 + ai * 128 + m * 16); const bf16* gp = G + rr * 2048 + 1024 + col0; bf16* op = MG + rr * 1024 + col0;
#pragma unroll
                    for (int bj = 0; bj < 2; ++bj) { const v4u g = *(const v4u*)(gp + bj * 128); const f32x4 v0 = acc[ai][bj][m][0] + bv[bj][0], v1 = acc[ai][bj][m][1] + bv[bj][1];
                        const f32x4* tg = tp + (size_t)(ai * 4 + m) * 2048 + bj * 2; f32x4 t0 = tg[0], t1 = tg[1]; v4u w;
#ifdef DBG_NO_T
                        t0 = (f32x4){0.f, 0.f, 0.f, 0.f}; t1 = t0;
#endif
                        w.x = pk2(t0[0] + v0[0] * bflo(g.x), t0[1] + v0[1] * bfhi(g.x)); w.y = pk2(t0[2] + v0[2] * bflo(g.y), t0[3] + v0[3] * bfhi(g.y));
                        w.z = pk2(t1[0] + v1[0] * bflo(g.z), t1[1] + v1[1] * bfhi(g.z)); w.w = pk2(t1[2] + v1[2] * bflo(g.w), t1[3] + v1[3] * bfhi(g.w));
                        *(v4u*)(op + bj * 128) = w;
#ifdef DBG_ACCOUT
                        { const f32x4 r0 = acc[ai][bj][m][0], r1 = acc[ai][bj][m][1]; v4u w2; w2.x = pk2(r0[0], r0[1]); w2.y = pk2(r0[2], r0[3]); w2.z = pk2(r1[0], r1[1]); w2.w = pk2(r1[2], r1[3]);
                          *(v4u*)(op + ((size_t)(450 - 209 - 192) << 20) / 2 + bj * 128) = w2; }
#endif
                        }
                    asm volatile("" ::: "memory"); }
        }
    }
};
struct PairOrder {
    pg8::StaticOrder so;
    __device__ __forceinline__ bool next(int i, Unit& u) const { Unit b; if (!so.next(i >> 1, b)) return false; const int sub = i & 1; u.pm = b.pm + 64 * sub; u.pn = b.pn + 4 * sub; return true; }
    __device__ __forceinline__ void a_ready(const Unit&) const {}
    __device__ __forceinline__ void done(const Unit&) const {}
};
struct EpiX1 {
    static constexpr bool PERM = false, AFTER_DRAIN = false;
    const float* X; float* O;
    __device__ __forceinline__ void operator()(const f32x4 (&acc)[2][2][4][2], const Unit& u, int wr, int wc, int fr, int fq) const {
        int row0 = u.pm * 256 + wr * 64 + fr, col0 = u.pn * 256 + wc * 32 + 4 * fq;
        asm volatile("" : "+v"(row0), "+v"(col0));
#pragma unroll
        for (int ai = 0; ai < 2; ++ai)
#pragma unroll
            for (int m = 0; m < 4; ++m) { const size_t off = (size_t)(row0 + ai * 128 + m * 16) * D + col0;
#pragma unroll
                for (int bj = 0; bj < 2; ++bj)
#pragma unroll
                    for (int n = 0; n < 2; ++n) { const f32x4 xv = *(const f32x4*)(X + off + bj * 128 + n * 16); *(f32x4*)(O + off + bj * 128 + n * 16) = xv + acc[ai][bj][m][n]; } }
    }
};
struct EpiSwiglu {
    static constexpr bool PERM = true, AFTER_DRAIN = false;
    bf16* ACT;
    __device__ __forceinline__ void operator()(const f32x4 (&acc)[2][2][4][2], const Unit& u, int wr, int wc, int fr, int fq) const {
        int row0 = u.pm * 256 + wr * 64 + fr, col0 = (u.pn & 3) * 128 + wc * 32 + 8 * fq;
        asm volatile("" : "+v"(row0), "+v"(col0));
#pragma unroll
        for (int ai = 0; ai < 2; ++ai)
#pragma unroll
            for (int m = 0; m < 4; ++m) { bf16* rowp = ACT + (size_t)(row0 + ai * 128 + m * 16) * 512 + col0;
                const f32x4 a0 = acc[ai][0][m][0], a1 = acc[ai][0][m][1], b0 = acc[ai][1][m][0], b1 = acc[ai][1][m][1]; v4u w;
                w.x = pk2(a0[0] * sigmoidf_(a0[0]) * b0[0], a0[1] * sigmoidf_(a0[1]) * b0[1]); w.y = pk2(a0[2] * sigmoidf_(a0[2]) * b0[2], a0[3] * sigmoidf_(a0[3]) * b0[3]);
                w.z = pk2(a1[0] * sigmoidf_(a1[0]) * b1[0], a1[1] * sigmoidf_(a1[1]) * b1[1]); w.w = pk2(a1[2] * sigmoidf_(a1[2]) * b1[2], a1[3] * sigmoidf_(a1[3]) * b1[3]);
                *(v4u*)rowp = w; }
    }
};
struct EpiDown {
    static constexpr bool PERM = true, AFTER_DRAIN = false;
    bf16* Y; const float* roww;
    __device__ __forceinline__ void operator()(const f32x4 (&acc)[2][2][4][2], const Unit& u, int wr, int wc, int fr, int fq) const {
        int row0 = u.pm * 256 + wr * 64 + fr, col0 = (u.pn & 3) * 256 + wc * 32 + 8 * fq;
        asm volatile("" : "+v"(row0), "+v"(col0));
#pragma unroll
        for (int ai = 0; ai < 2; ++ai)
#pragma unroll
            for (int m = 0; m < 4; ++m) { const int rr = row0 + ai * 128 + m * 16; const float sc = roww[rr]; bf16* rowp = Y + (size_t)rr * 1024 + col0;
#pragma unroll
                for (int bj = 0; bj < 2; ++bj) { const f32x4 v0 = acc[ai][bj][m][0] * sc, v1 = acc[ai][bj][m][1] * sc; v4u w;
                    w.x = pk2(v0[0], v0[1]); w.y = pk2(v0[2], v0[3]); w.z = pk2(v1[0], v1[1]); w.w = pk2(v1[2], v1[3]);
                    *(v4u*)(rowp + bj * 128) = w; } }
    }
};
struct MoeOrder {
    const LAS int* te; int ntile, G, c;
    __device__ __forceinline__ bool next(int i, Unit& u) const { const int L = i * G + c; if (L >= ntile * 4) return false; const int mt = L >> 2; u.pm = mt; u.pn = te[mt] * 4 + (L & 3); return true; }
    __device__ __forceinline__ void a_ready(const Unit&) const {}
    __device__ __forceinline__ void done(const Unit&) const {}
};
__device__ __forceinline__ void moe_tables(Frame& F) {
    LAS int* tab = (LAS int*)(F.lds + MOE_TAB_OFF);
    __syncthreads();
    if (F.tid < NE) tab[F.tid] = (int)__hip_atomic_load(F.ctl + CW_GCNT + 64 * F.tid, RLX_AGENT);
    __syncthreads();
    if (F.tid == 0) { int pt = 0;
        for (int e = 0; e < NE; ++e) { tab[64 + e] = pt; const int nt = (tab[e] + 255) >> 8; for (int k = 0; k < nt; ++k) tab[129 + pt + k] = e; pt += nt; }
        tab[64 + NE] = pt; tab[129 + MAXTILES] = pt; }
    __syncthreads();
}

__device__ __forceinline__ void conv_unit(Frame& F, int unit) {
    LAS unsigned char* lds = F.lds + RING_OFF;
    const int tid = F.tid, lane = F.lane, w = F.wave;
    const int row0 = unit * 32, b = row0 / SEQ, t0 = row0 % SEQ;
    for (int p = tid; p < 62 * 64; p += 512) { const int r = p >> 6, ch = p & 63; const int t = t0 - 30 + r;
        v4u v = (v4u){0u, 0u, 0u, 0u}; if (t >= 0) v = *(const GAS v4u*)(F.U + ((size_t)b * SEQ + t) * 512 + ch * 8);
        *(LAS v4u*)(lds + r * 1024 + ch * 16) = v; }
    __syncthreads();
    {   const int c = tid; float wt[CK];
#pragma unroll
        for (int j = 0; j < CK; ++j) wt[j] = F.w_dw[j * 512 + c];
        const float bias = F.b_dw[c];
        const LAS unsigned short* in = (const LAS unsigned short*)lds + c; LAS float* yo = (LAS float*)(lds + 63488) + c;
        for (int r = 0; r < 32; ++r) { float a = bias;
#pragma unroll
            for (int j = 0; j < CK; ++j) a += wt[j] * bf2f(in[(r + j) * 512]);
            yo[r * 512] = a; } }
    __syncthreads();
    {   const f32x4 g0 = *(const GAS f32x4*)(F.g_cln + lane * 8), g1 = *(const GAS f32x4*)(F.g_cln + lane * 8 + 4), b0 = *(const GAS f32x4*)(F.b_cln + lane * 8), b1 = *(const GAS f32x4*)(F.b_cln + lane * 8 + 4);
#pragma unroll
        for (int k = 0; k < 4; ++k) { const int r = w * 4 + k; const LAS f32x4* yp = (const LAS f32x4*)(lds + 63488 + r * 2048) + lane * 2;
            f32x4 v0 = yp[0], v1 = yp[1];
            const float mean = wave_sum((v0.x + v0.y) + (v0.z + v0.w) + (v1.x + v1.y) + (v1.z + v1.w)) * (1.f / 512.f);
            v0 = v0 - mean; v1 = v1 - mean;
            const float var = wave_sum((v0.x * v0.x + v0.y * v0.y) + (v0.z * v0.z + v0.w * v0.w) + (v1.x * v1.x + v1.y * v1.y) + (v1.z * v1.z + v1.w * v1.w)) * (1.f / 512.f);
            const float rs = rsqrtf(var + EPS);
            v0 = v0 * rs * g0 + b0; v1 = v1 * rs * g1 + b1;
            v4u o; o.x = pk2(v0.x * sigmoidf_(v0.x), v0.y * sigmoidf_(v0.y)); o.y = pk2(v0.z * sigmoidf_(v0.z), v0.w * sigmoidf_(v0.w));
            o.z = pk2(v1.x * sigmoidf_(v1.x), v1.y * sigmoidf_(v1.y)); o.w = pk2(v1.z * sigmoidf_(v1.z), v1.w * sigmoidf_(v1.w));
            *(GAS v4u*)(F.UC + (size_t)(row0 + r) * 512 + lane * 8) = o; } }
    __syncthreads();
}

__device__ __forceinline__ int rel_bucket_dev(int d) {
    const int n = d < 0 ? -d : d; int v;
    if (n < 8) v = n; else if (n < 12) v = 8; else if (n < 16) v = 9; else if (n < 23) v = 10; else if (n < 32) v = 11; else if (n < 46) v = 12; else if (n < 64) v = 13; else if (n < 91) v = 14; else v = 15;
    return (d < 0 ? 16 : 0) + v;
}
__device__ __forceinline__ void attn_unit(Frame& F, int b, int h, int qi, float lam) {
    LAS unsigned char* lds = F.lds + RING_OFF;
    const int tid = F.tid, lane = F.lane, w = F.wave, mp = w >> 2, rg = w & 3, r32 = lane & 31, hi = lane >> 5;
    const int q0 = qi * 128, qw0 = q0 + rg * 32, qrow = qw0 + r32;
    const size_t rowb = (size_t)b * SEQ;
    const int cw = qw0 >> 6, cmax = (q0 >> 6) + 1;
    bf16x8 qf[4];
    {   const bf16* qp = F.Qb + (rowb + qrow) * 512 + h * 128 + mp * 64 + hi * 8;
#pragma unroll
        for (int d0 = 0; d0 < 4; ++d0) qf[d0] = *(const GAS bf16x8*)(qp + d0 * 16); }
    const int prow = tid >> 4, pch = tid & 15;
    const bf16* kg = F.Kb + (rowb + prow) * 512 + h * 128 + pch * 8;
    const bf16* vg = F.Vb + (rowb + prow) * 512 + h * 128 + pch * 8;
    const int kofs = (pch >> 3) * 8192 + prow * 128 + (((pch & 7) ^ ((prow >> 1) & 7)) << 4);
    const int vofs = 16384 + prow * 256 + ((pch * 16) ^ ((prow & 3) << 6));
    v4u kr0, kr1, vr0, vr1;
#define ATT_LOAD(j) do { const size_t go_ = (size_t)(j) * 64 * 512; kr0 = *(const GAS v4u*)(kg + go_); kr1 = *(const GAS v4u*)(kg + go_ + 32 * 512); vr0 = *(const GAS v4u*)(vg + go_); vr1 = *(const GAS v4u*)(vg + go_ + 32 * 512); } while (0)
#define ATT_STORE(bf) do { LAS unsigned char* b_ = lds + (bf) * 32768; *(LAS v4u*)(b_ + kofs) = kr0; *(LAS v4u*)(b_ + kofs + 4096) = kr1; *(LAS v4u*)(b_ + vofs) = vr0; *(LAS v4u*)(b_ + vofs + 8192) = vr1; } while (0)
    ATT_LOAD(0); ATT_STORE(0);
    __syncthreads();
    f32x16 o[4];
#pragma unroll
    for (int vb = 0; vb < 4; ++vb)
#pragma unroll
        for (int r = 0; r < 16; ++r) o[vb][r] = 0.f;
    float m_run = -1e30f, l_run = 0.f;
    const LAS float* btab = (const LAS float*)(F.lds + ATT_TAB_OFF) + h * 192;
    const float c15 = btab[191];
    const int kfo = r32 * 128, ksw = (r32 >> 1) & 7;
    const int vsw = (lane & 15) >> 2;
    const int vrow = (4 * hi + vsw) * 256 + 32 * ((lane >> 4) & 1) + 8 * (lane & 3);
    for (int j = 0; j <= cmax; ++j) {
        const int buf = j & 1;
        if (j < cmax) ATT_LOAD(j + 1);
        if (j <= cw) {
            const LAS unsigned char* kb = lds + buf * 32768 + mp * 8192;
            const LAS unsigned char* vbp = lds + buf * 32768 + 16384;
            const bool far = (64 * j + 154 <= qw0);
            const float ci = far ? c15 : 0.f;
            f32x16 p0, p1;
#pragma unroll
            for (int r = 0; r < 16; ++r) { p0[r] = ci; p1[r] = ci; }
#pragma unroll
            for (int d0 = 0; d0 < 4; ++d0) { const int off = kfo + (((d0 * 2 + hi) ^ ksw) << 4);
                const bf16x8 a0 = *(const LAS bf16x8*)(kb + off), a1 = *(const LAS bf16x8*)(kb + off + 4096);
                p0 = __builtin_amdgcn_mfma_f32_32x32x16_bf16(a0, qf[d0], p0, 0, 0, 0);
                p1 = __builtin_amdgcn_mfma_f32_32x32x16_bf16(a1, qf[d0], p1, 0, 0, 0); }
            if (!far) { const int dq = qrow - 64 * j + 63;
#pragma unroll
                for (int r = 0; r < 16; ++r) { const int kk = crow(r, hi); int i0 = dq - kk; i0 = i0 > 191 ? 191 : i0; int i1 = dq - kk - 32; i1 = i1 > 191 ? 191 : i1; p0[r] += btab[i0]; p1[r] += btab[i1]; } }
            float mx = fmaxf(p0[0], p1[0]);
#pragma unroll
            for (int r = 1; r < 16; ++r) mx = fmaxf(mx, fmaxf(p0[r], p1[r]));
            mx = xhalf_max(mx);
            const float m_new = fmaxf(m_run, mx);
            const float alpha = __builtin_amdgcn_exp2f(m_run - m_new);
            float s = 0.f;
#pragma unroll
            for (int r = 0; r < 16; ++r) { p0[r] = __builtin_amdgcn_exp2f(p0[r] - m_new); p1[r] = __builtin_amdgcn_exp2f(p1[r] - m_new); s += p0[r] + p1[r]; }
            l_run = l_run * alpha + s; m_run = m_new;
            if (!__all(alpha == 1.f)) {
#pragma unroll
                for (int vb = 0; vb < 4; ++vb)
#pragma unroll
                    for (int r = 0; r < 16; ++r) o[vb][r] *= alpha; }
            bf16x8 pf[4];
            {   v4u t;
                t.x = pk2(p0[0], p0[1]); t.y = pk2(p0[2], p0[3]); t.z = pk2(p0[4], p0[5]); t.w = pk2(p0[6], p0[7]); pf[0] = __builtin_bit_cast(bf16x8, t);
                t.x = pk2(p0[8], p0[9]); t.y = pk2(p0[10], p0[11]); t.z = pk2(p0[12], p0[13]); t.w = pk2(p0[14], p0[15]); pf[1] = __builtin_bit_cast(bf16x8, t);
                t.x = pk2(p1[0], p1[1]); t.y = pk2(p1[2], p1[3]); t.z = pk2(p1[4], p1[5]); t.w = pk2(p1[6], p1[7]); pf[2] = __builtin_bit_cast(bf16x8, t);
                t.x = pk2(p1[8], p1[9]); t.y = pk2(p1[10], p1[11]); t.z = pk2(p1[12], p1[13]); t.w = pk2(p1[14], p1[15]); pf[3] = __builtin_bit_cast(bf16x8, t); }
#pragma unroll
            for (int vb = 0; vb < 4; ++vb) { const LAS unsigned char* vp = vbp + vrow + ((vb ^ vsw) << 6);
#pragma unroll
                for (int ks = 0; ks < 4; ++ks) {
                    const s16x4 lo = __builtin_bit_cast(s16x4, __builtin_amdgcn_ds_read_tr16_b64_v4i16((LAS s16x4*)(vp + ks * 4096)));
                    const s16x4 hh = __builtin_bit_cast(s16x4, __builtin_amdgcn_ds_read_tr16_b64_v4i16((LAS s16x4*)(vp + ks * 4096 + 2048)));
                    const bf16x8 va = (bf16x8){lo[0], lo[1], lo[2], lo[3], hh[0], hh[1], hh[2], hh[3]};
                    o[vb] = __builtin_amdgcn_mfma_f32_32x32x16_bf16(va, pf[ks], o[vb], 0, 0, 0); } }
        }
        if (j < cmax) ATT_STORE((j + 1) & 1);
        __syncthreads();
    }
#undef ATT_LOAD
#undef ATT_STORE
    const float inv = 1.f / xhalf_sum(l_run);
    LAS float* X = (LAS float*)(lds + 65536) + rg * 4096 + lane;
    if (mp == 1) {
#pragma unroll
        for (int vb = 0; vb < 4; ++vb)
#pragma unroll
            for (int r = 0; r < 16; ++r) X[(vb * 16 + r) * 64] = o[vb][r] * inv; }
    __syncthreads();
    if (mp == 0) {
        float ss = 0.f;
#pragma unroll
        for (int vb = 0; vb < 4; ++vb)
#pragma unroll
            for (int r = 0; r < 16; ++r) { const float v = o[vb][r] * inv - lam * X[(vb * 16 + r) * 64]; o[vb][r] = v; ss += v * v; }
        ss = xhalf_sum(ss);
        const float rs = rsqrtf(ss * (1.f / 128.f) + EPS) * 0.8f;
        bf16* op = F.AO + (rowb + qrow) * 512 + h * 128;
#pragma unroll
        for (int vb = 0; vb < 4; ++vb)
#pragma unroll
            for (int rq = 0; rq < 4; ++rq) { const int v0 = vb * 32 + 8 * rq + 4 * hi; const f32x4 g = *(const GAS f32x4*)(F.gsub + v0); v2u ow;
                ow.x = pk2(o[vb][4 * rq + 0] * rs * g.x, o[vb][4 * rq + 1] * rs * g.y); ow.y = pk2(o[vb][4 * rq + 2] * rs * g.z, o[vb][4 * rq + 3] * rs * g.w);
                *(GAS v2u*)(op + v0) = ow; }
    }
}
__device__ __forceinline__ void p2_mixers(Frame& F) {
#ifdef DBG_NO_CONV
    for (size_t i = (size_t)blockIdx.x * 512 + F.tid; i < (size_t)M * 512 * 2 / 16; i += (size_t)F.G * 512) ((GAS v4u*)F.UC)[i] = (v4u){0u, 0u, 0u, 0u};
#else
    for (int u = F.vcu; u < M / 32; u += F.G) conv_unit(F, u);
#endif
    {   LAS float* bt = (LAS float*)(F.lds + ATT_TAB_OFF);
        for (int i = F.tid; i < NH * 192; i += 512) { const int h = i / 192, d = i % 192 - 63; bt[i] = F.relb[rel_bucket_dev(d) * NH + h] * LOG2E; } }
    float lam;
    {   const float a = wave_sum(F.lq1[F.lane] * F.lk1[F.lane]), c = wave_sum(F.lq2[F.lane] * F.lk2[F.lane]); lam = __expf(a) - __expf(c) + 0.2f; }
    __syncthreads();
#ifdef DBG_NO_ATT
    for (size_t i = (size_t)blockIdx.x * 512 + F.tid; i < (size_t)M * 512 * 2 / 16; i += (size_t)F.G * 512) ((GAS v4u*)F.AO)[i] = (v4u){0u, 0u, 0u, 0u};
    if (lam == 123.f) F.AO[0] = 1;
#else
    for (int v = F.vcu; v < 256; v += F.G) { const int bh = v >> 4, s = v & 15;
        attn_unit(F, bh >> 2, bh & 3, s, lam);
        attn_unit(F, bh >> 2, bh & 3, 31 - s, lam); }
#endif
    __syncthreads();
}

typedef float f32x4v __attribute__((ext_vector_type(4)));
__device__ __forceinline__ void p5a_router(Frame& F) {
    LAS unsigned char* lds = F.lds + RING_OFF;
    LAS float* LP = (LAS float*)lds;
    LAS float* SS = (LAS float*)(lds + 40960);
    LAS int* lcnt = (LAS int*)(lds + 40960 + 512);
    LAS int* lbase = (LAS int*)(lds + 40960 + 768);
    const int tid = F.tid, lane = F.lane, w = F.wave, rt = w & 3, kh = w >> 2, r16 = lane & 15, kq = lane >> 4;
    for (int blk = F.vcu; blk < M / 64; blk += F.G) {
        if (tid < 64) lcnt[tid] = 0;
        {   const int row = blk * 64 + rt * 16 + r16;
            const float* xp = F.out + (size_t)row * D + kh * 512 + 4 * kq;
            const GAS f32x4* wf = (const GAS f32x4*)F.Wrf + (size_t)(kh * 32) * 5 * 64 + lane;
            f32x4 acc[5]; float ss = 0.f;
#pragma unroll
            for (int ct = 0; ct < 5; ++ct) acc[ct] = (f32x4){0.f, 0.f, 0.f, 0.f};
#pragma unroll 2
            for (int kc = 0; kc < 32; ++kc) {
                const f32x4 a = *(const GAS f32x4*)(xp + kc * 16);
                f32x4 bw[5];
#pragma unroll
                for (int ct = 0; ct < 5; ++ct) bw[ct] = wf[(kc * 5 + ct) * 64];
                ss += (a.x * a.x + a.y * a.y) + (a.z * a.z + a.w * a.w);
#pragma unroll
                for (int ct = 0; ct < 5; ++ct) {
                    acc[ct] = __builtin_amdgcn_mfma_f32_16x16x4f32(a.x, bw[ct].x, acc[ct], 0, 0, 0);
                    acc[ct] = __builtin_amdgcn_mfma_f32_16x16x4f32(a.y, bw[ct].y, acc[ct], 0, 0, 0);
                    acc[ct] = __builtin_amdgcn_mfma_f32_16x16x4f32(a.z, bw[ct].z, acc[ct], 0, 0, 0);
                    acc[ct] = __builtin_amdgcn_mfma_f32_16x16x4f32(a.w, bw[ct].w, acc[ct], 0, 0, 0); }
            }
            ss += __shfl_xor(ss, 16); ss += __shfl_xor(ss, 32);
            if (kq == 0) SS[kh * 64 + rt * 16 + r16] = ss;
#pragma unroll
            for (int ct = 0; ct < 5; ++ct)
#pragma unroll
                for (int rg = 0; rg < 4; ++rg) LP[(kh * 64 + rt * 16 + 4 * kq + rg) * 80 + ct * 16 + r16] = acc[ct][rg];
        }
        __syncthreads();
        int e0 = 0, e1 = 0, rk0 = 0, rk1 = 0; float w0 = 0.f, w1 = 0.f, rstd = 0.f;
        if (tid < 64) {
            const int r = tid; const LAS float* l0 = LP + r * 80; const LAS float* l1 = LP + (64 + r) * 80;
            rstd = rsqrtf((SS[r] + SS[64 + r]) * (1.f / D) + EPS);
            float lg[8]; int grp = 0; float mx = -3.0e38f;
#pragma unroll
            for (int g = 0; g < 8; ++g) { lg[g] = (l0[g] + l1[g]) * rstd + F.b_rg[g]; if (lg[g] > mx) { mx = lg[g]; grp = g; } }
            float den = 0.f;
#pragma unroll
            for (int g = 0; g < 8; ++g) den += __expf(lg[g] - mx);
            const float pg = 1.f / den;
            float v0 = -3.0e38f, v1 = -3.0e38f; int j0 = 0, j1 = 0;
            for (int j = 0; j < 8; ++j) { const float le = (l0[8 + grp * 8 + j] + l1[8 + grp * 8 + j]) * rstd + F.b_re[grp * 8 + j];
                if (le > v0) { v1 = v0; j1 = j0; v0 = le; j0 = j; } else if (le > v1) { v1 = le; j1 = j; } }
            w0 = pg / (1.f + __expf(v1 - v0)); w1 = pg - w0;
            e0 = grp * 8 + j0; e1 = grp * 8 + j1;
            rk0 = __hip_atomic_fetch_add(lcnt + e0, 1, __ATOMIC_RELAXED, __HIP_MEMORY_SCOPE_WORKGROUP);
            rk1 = __hip_atomic_fetch_add(lcnt + e1, 1, __ATOMIC_RELAXED, __HIP_MEMORY_SCOPE_WORKGROUP);
        }
        __syncthreads();
        if (tid < 64) { const int c = lcnt[tid]; lbase[tid] = c > 0 ? (int)__hip_atomic_fetch_add(F.ctl + CW_GCNT + 64 * tid, (unsigned)c, RLX_AGENT) : 0; }
        __syncthreads();
        if (tid < 64) { int* ti = F.tokinfo + (size_t)(blk * 64 + tid) * 8;
            ti[0] = e0; ti[1] = e1; ti[2] = lbase[e0] + rk0; ti[3] = lbase[e1] + rk1; ti[4] = __float_as_int(w0); ti[5] = __float_as_int(w1); ti[6] = __float_as_int(rstd); ti[7] = 0; }
        __syncthreads();
    }
}
__device__ __forceinline__ void p5b_gather(Frame& F) {
    moe_tables(F);
    const LAS int* tab = (const LAS int*)(F.lds + MOE_TAB_OFF);
    LAS int* rowinfo = (LAS int*)(F.lds + RING_OFF);
    const int tid = F.tid, lane = F.lane, w = F.wave;
    for (int blk = F.vcu; blk < M / 64; blk += F.G) {
        if (tid < 64) { const int t = blk * 64 + tid; const int* ti = F.tokinfo + (size_t)t * 8;
            const int e0 = ti[0], e1 = ti[1]; const int s0 = tab[64 + e0] * 256 + ti[2], s1 = tab[64 + e1] * 256 + ti[3];
            F.tokslot[2 * t] = s0; F.tokslot[2 * t + 1] = s1; F.roww[s0] = __int_as_float(ti[4]); F.roww[s1] = __int_as_float(ti[5]);
            rowinfo[tid * 4 + 0] = s0; rowinfo[tid * 4 + 1] = s1; rowinfo[tid * 4 + 2] = ti[6]; }
        __syncthreads();
#pragma unroll 2
        for (int k = 0; k < 8; ++k) { const int r = w * 8 + k, t = blk * 64 + r; const int s0 = rowinfo[r * 4], s1 = rowinfo[r * 4 + 1]; const float rstd = __int_as_float(rowinfo[r * 4 + 2]);
            const float* xr = F.out + (size_t)t * D;
#pragma unroll
            for (int hf = 0; hf < 2; ++hf) { const int c = hf * 512 + lane * 8;
                const f32x4 a = *(const GAS f32x4*)(xr + c), b = *(const GAS f32x4*)(xr + c + 4), ga = *(const GAS f32x4*)(F.g_ffn + c), gb = *(const GAS f32x4*)(F.g_ffn + c + 4); v4u o;
                o.x = pk2(a.x * rstd * ga.x, a.y * rstd * ga.y); o.y = pk2(a.z * rstd * ga.z, a.w * rstd * ga.w); o.z = pk2(b.x * rstd * gb.x, b.y * rstd * gb.y); o.w = pk2(b.z * rstd * gb.z, b.w * rstd * gb.w);
                *(GAS v4u*)(F.XG + (size_t)s0 * D + c) = o; *(GAS v4u*)(F.XG + (size_t)s1 * D + c) = o; } }
        __syncthreads();
    }
}
__device__ __forceinline__ void p8_final(Frame& F) {
    const int gw = F.vcu * NWAVES + F.wave, NGW = F.G * NWAVES, lane = F.lane;
    for (int m = gw; m < M; m += NGW) {
#ifdef DBG_NOMOE
        const int s0 = 0, s1 = 0;
#else
        const int s0 = F.tokslot[2 * m], s1 = F.tokslot[2 * m + 1];
#endif
        GAS f32x4* xr = (GAS f32x4*)(F.out + (size_t)m * D) + lane; const GAS v2u* y0 = (const GAS v2u*)(F.Y + (size_t)s0 * D) + lane; const GAS v2u* y1 = (const GAS v2u*)(F.Y + (size_t)s1 * D) + lane;
        const GAS f32x4* gr = (const GAS f32x4*)F.g_fin + lane;
        f32x4 v[4]; float s = 0.f;
#pragma unroll
        for (int j = 0; j < 4; ++j) { const f32x4 xv = xr[64 * j]; v2u a = y0[64 * j], b = y1[64 * j];
#ifdef DBG_NOMOE
            a = (v2u){0u, 0u}; b = (v2u){0u, 0u};
#endif
            v[j].x = xv.x + (bflo(a.x) + bflo(b.x)); v[j].y = xv.y + (bfhi(a.x) + bfhi(b.x)); v[j].z = xv.z + (bflo(a.y) + bflo(b.y)); v[j].w = xv.w + (bfhi(a.y) + bfhi(b.y));
            s += (v[j].x * v[j].x + v[j].y * v[j].y) + (v[j].z * v[j].z + v[j].w * v[j].w); }
#ifdef DBG_ACCOUT
        { const GAS v2u* dbg = (const GAS v2u*)(F.MG + ((size_t)(450 - 209 - 192) << 20) / 2 + (size_t)m * D) + lane;
#pragma unroll
          for (int j = 0; j < 4; ++j) { const v2u a = dbg[64 * j]; v[j] = (f32x4){bflo(a.x), bfhi(a.x), bflo(a.y), bfhi(a.y)}; } s = 1024.f / 64.f; }
#endif
#ifdef DBG_OUTSRC
        { const bf16* srcb = DBG_OUTSRC == 1 ? F.XN + (size_t)m * 1024 : DBG_OUTSRC == 2 ? F.Gt + (size_t)m * 2048 : DBG_OUTSRC == 3 ? F.Gt + (size_t)m * 2048 + 1024 : DBG_OUTSRC == 4 ? F.Qb + (size_t)m * 512 : DBG_OUTSRC == 5 ? F.Vb + (size_t)m * 512 : DBG_OUTSRC == 7 ? F.Win_t + (size_t)(m % 4608) * 1024 : F.U + (size_t)m * 512;
          const GAS v2u* dbg = (const GAS v2u*)srcb + lane;
#pragma unroll
          for (int j = 0; j < 4; ++j) { const v2u a = dbg[(DBG_OUTSRC >= 4 ? (j & 1) : j) * 64]; v[j] = (f32x4){bflo(a.x), bfhi(a.x), bflo(a.y), bfhi(a.y)}; } s = 1024.f / 64.f; }
#endif
        const float rs = rsqrtf(wave_sum(s) * (1.f / D) + EPS);
#pragma unroll
        for (int j = 0; j < 4; ++j) { const f32x4 g = gr[64 * j]; xr[64 * j] = (f32x4){v[j].x * rs * g.x, v[j].y * rs * g.y, v[j].z * rs * g.z, v[j].w * rs * g.w}; }
    }
}

struct Args { const float* in[26]; float* out; unsigned char* ws; int ph_lo, ph_hi; };
__global__ void __launch_bounds__(NWAVES * 64, 2) fwd_kernel(Args args) {
    extern __shared__ __attribute__((aligned(16))) unsigned char lds[];
    Frame F;
    F.lds = (LAS unsigned char*)lds;
    F.tid = threadIdx.x; F.lane = F.tid & 63; F.wave = __builtin_amdgcn_readfirstlane(F.tid >> 6);
    F.G = gridDim.x; { const int bx = blockIdx.x; F.vcu = (F.G % 8 == 0) ? (bx % 8) * (F.G / 8) + bx / 8 : bx; }
    unsigned char* ws = args.ws;
    F.ctl = (gu32*)(ws + WS_CTL);
    F.x = args.in[0]; F.w_in = args.in[1]; F.lq1 = args.in[2]; F.lk1 = args.in[3]; F.lq2 = args.in[4]; F.lk2 = args.in[5]; F.gsub = args.in[6]; F.relb = args.in[7];
    F.w_au = args.in[8]; F.w_dw = args.in[9]; F.b_dw = args.in[10]; F.g_cln = args.in[11]; F.b_cln = args.in[12]; F.w_pw = args.in[13]; F.b_pw = args.in[14]; F.w_out = args.in[15];
    F.g_mix = args.in[16]; F.g_ffn = args.in[17]; F.w_rg = args.in[18]; F.b_rg = args.in[19]; F.w_re = args.in[20]; F.b_re = args.in[21]; F.w_eg = args.in[22]; F.w_eu = args.in[23]; F.w_ed = args.in[24]; F.g_fin = args.in[25];
    F.out = args.out;
    F.Win_t = (bf16*)(ws + WS_WIN); F.Wmix_t = (bf16*)(ws + WS_WMIX); F.Wout_t = (bf16*)(ws + WS_WOUT); F.Wgu_t = (bf16*)(ws + WS_WGU); F.Wd_t = (bf16*)(ws + WS_WD);
    F.XN = (bf16*)(ws + WS_XN); F.Qb = (bf16*)(ws + WS_Q); F.Kb = (bf16*)(ws + WS_K); F.Vb = (bf16*)(ws + WS_V); F.U = (bf16*)(ws + WS_U); F.Gt = (bf16*)(ws + WS_G);
    F.AO = (bf16*)(ws + WS_AO); F.UC = (bf16*)(ws + WS_UC); F.MG = (bf16*)(ws + WS_MG); F.XG = (bf16*)(ws + WS_XG); F.ACT = (bf16*)(ws + WS_ACT); F.Y = (bf16*)(ws + WS_Y);
    F.T = (float*)(ws + WS_T); F.Wrf = (float*)(ws + WS_WRF); F.roww = (float*)(ws + WS_ROWW); F.tokinfo = (int*)(ws + WS_TOKINFO); F.tokslot = (int*)(ws + WS_TOKSLOT);
    for (int u = F.tid; u < 128; u += NWAVES * 64) ((LAS unsigned*)(F.lds + LDSCTL_OFF))[u] = 0u;
    __syncthreads();
    const int lo = args.ph_lo, hi = args.ph_hi;
    XcdBarrier bar; bar.bar = (unsigned*)(F.ctl + CW_BAR); bar.x = 0; bar.st = nullptr;
    if (hi - lo > 1) bar = xcd_barrier_post((unsigned*)(F.ctl + CW_BAR), (volatile LAS unsigned*)(F.lds + LDSCTL_OFF) + 8);
#ifndef PH_MASK
#define PH_MASK 0x3ff
#endif
#define IN(k) (((PH_MASK >> (k)) & 1) && lo <= (k) && (k) < hi)
#define SEAM(k) do { if (IN(k) && IN((k) + 1)) xcd_barrier(bar); } while (0)
    constexpr bool AL = true, SP = true;

    if (IN(0)) { p0_prologue(F); SEAM(0); }
    if (IN(1)) {
        pg8::Gemm g{F.XN, F.Win_t, M, NCOL, D}; pg8::StaticOrder S; S.init(M, NCOL, F.G, (int)blockIdx.x);
        EpiProj E{F.Qb, F.Kb, F.Vb, F.U, F.Gt};
        pg8::gemm_phase<EpiProj, pg8::StaticOrder, AL, SP>(F.lds + RING_OFF, g, S, E);
        SEAM(1);
    }
#if defined(DBG_ZERO_P2)
    if (IN(2)) { for (size_t i = (size_t)blockIdx.x * 512 + F.tid; i < (size_t)M * 1024 * 2 / 16; i += (size_t)F.G * 512) ((GAS v4u*)F.AO)[i] = ((const GAS v4u*)F.XN)[i]; SEAM(2); }
#else
    if (IN(2)) { p2_mixers(F); SEAM(2); }
#endif
    if (IN(3)) {
        pg8::Gemm g{F.AO, F.Wmix_t, 2 * M, 2048, 512}; PairOrder S; S.so.init(M, 1024, F.G, (int)blockIdx.x);
        EpiMerge E{F.Gt, F.b_pw, F.T + (size_t)blockIdx.x * 65536, F.MG};
        pg8::gemm_phase<EpiMerge, PairOrder, AL, SP>(F.lds + RING_OFF, g, S, E);
        SEAM(3);
    }
    if (IN(4)) {
        pg8::Gemm g{F.MG, F.Wout_t, M, D, D}; pg8::StaticOrder S; S.init(M, D, F.G, (int)blockIdx.x);
        EpiX1 E{F.x, F.out};
        pg8::gemm_phase<EpiX1, pg8::StaticOrder, AL, SP>(F.lds + RING_OFF, g, S, E);
        SEAM(4);
    }
    if (IN(5)) { p5a_router(F); SEAM(5); }
    if (IN(6)) { p5b_gather(F); SEAM(6); }
    if (IN(7)) {
        moe_tables(F);
        const LAS int* tab = (const LAS int*)(F.lds + MOE_TAB_OFF);
        pg8::Gemm g{F.XG, F.Wgu_t, MAXTILES * 256, NE * 1024, D}; MoeOrder S{tab + 129, tab[129 + MAXTILES], F.G, F.vcu};
        EpiSwiglu E{F.ACT};
        pg8::gemm_phase<EpiSwiglu, MoeOrder, AL, SP>(F.lds + RING_OFF, g, S, E);
        SEAM(7);
    }
    if (IN(8)) {
        moe_tables(F);
        const LAS int* tab = (const LAS int*)(F.lds + MOE_TAB_OFF);
        pg8::Gemm g{F.ACT, F.Wd_t, MAXTILES * 256, NE * 1024, DE}; MoeOrder S{tab + 129, tab[129 + MAXTILES], F.G, F.vcu};
        EpiDown E{F.Y, F.roww};
        pg8::gemm_phase<EpiDown, MoeOrder, AL, SP>(F.lds + RING_OFF, g, S, E);
        SEAM(8);
    }
    if (IN(9)) { p8_final(F); }
#undef IN
#undef SEAM
}

#ifndef MK_N_LAUNCHES
#define MK_N_LAUNCHES 1
#endif
extern "C" void kernel_launch(void* const* d_in, const int* in_sizes, int n_in, void* d_out, int out_size, void* d_ws, size_t ws_size, hipStream_t stream) {
    static int grid = 0;
    if (grid == 0) {
        if (n_in != 26 || in_sizes[0] != M * D || out_size != M * D || ws_size < WS_END) { fprintf(stderr, "kernel_launch: unexpected shapes (n_in %d, in0 %d, out %d, ws %zu < %zu)\n", n_in, n_in > 0 ? in_sizes[0] : -1, out_size, ws_size, (size_t)WS_END); grid = -1; return; }
        int dev = 0, cus = 0, per_cu = 0;
        if (hipGetDevice(&dev) != hipSuccess || hipDeviceGetAttribute(&cus, hipDeviceAttributeMultiprocessorCount, dev) != hipSuccess) { grid = -1; return; }
        if (hipFuncSetAttribute((const void*)fwd_kernel, hipFuncAttributeMaxDynamicSharedMemorySize, LDS_BYTES) != hipSuccess) { fprintf(stderr, "kernel_launch: hipFuncSetAttribute failed\n"); grid = -1; return; }
        if (hipOccupancyMaxActiveBlocksPerMultiprocessor(&per_cu, (const void*)fwd_kernel, NWAVES * 64, LDS_BYTES) != hipSuccess || per_cu < 1)
            fprintf(stderr, "kernel_launch: occupancy query reports %d workgroups per CU\n", per_cu);
        (void)hipGetLastError();
        grid = cus;
    }
    if (grid < 0) return;
    if (hipMemsetAsync((char*)d_ws + WS_CTL, 0, CTL_ZERO_BYTES, stream) != hipSuccess) return;
    Args a{};
    for (int i = 0; i < 26; ++i) a.in[i] = (const float*)d_in[i];
    a.out = (float*)d_out; a.ws = (unsigned char*)d_ws;
#if MK_N_LAUNCHES == 1
    a.ph_lo = 0; a.ph_hi = NPHASE;
    hipLaunchKernelGGL(fwd_kernel, dim3(grid), dim3(NWAVES * 64), LDS_BYTES, stream, a);
#else
    for (int p = 0; p < NPHASE; ++p) { a.ph_lo = p; a.ph_hi = p + 1; hipLaunchKernelGGL(fwd_kernel, dim3(grid), dim3(NWAVES * 64), LDS_BYTES, stream, a); }
#endif
}
```

```cpp
#include <hip/hip_runtime.h>
#include <cstdio>
#include <cstdint>
#define MK_N_LAUNCHES 1
#define REP_MASK 0
namespace pg8 {
#define PG8_LAS __attribute__((address_space(3)))
typedef unsigned short bf16_t;
typedef short bf16x8 __attribute__((ext_vector_type(8)));
typedef float f32x4 __attribute__((ext_vector_type(4)));
typedef unsigned u32x4 __attribute__((ext_vector_type(4)));
constexpr int BM = 256, BK = 64, HALF = 128, HTB = HALF * BK * 2  , STAGE_BYTES = 8 * HTB, NXCD = 8, WGM = 8;

__host__ __device__ __forceinline__ int lds_byte(int r, int c) { const int st = (r >> 4) * 2 + (c >> 5), rr = r & 15, cc = c & 31, ob = rr * 64 + cc * 2; return st * 1024 + (ob ^ (((ob >> 9) & 1) << 5)); }
__host__ __device__ __forceinline__ void stage_rc(int b, int& R, int& C) { const int st = b / 1024, sb = b % 1024, swz = sb ^ (((sb >> 9) & 1) << 5); R = (st >> 1) * 16 + swz / 64; C = (st & 1) * 32 + (swz % 64) / 2; }
__host__ __device__ __forceinline__ int perm32(int rho) { const int n = rho >> 4, i = rho & 15; return 8 * (i >> 2) + 4 * n + (i & 3); }

struct Unit { int pm, pn; };
struct Gemm { const bf16_t* A; const bf16_t* Bt; int M, N, K; };

struct StaticOrder {
    int nM, nN, nwg, G, c;
    __host__ __device__ void init(int M, int N, int G_, int c_) { nM = M / BM; nN = N / BM; nwg = nM * nN; G = G_; c = c_; }
    __host__ __device__ bool next(int i, Unit& u) const {
        const long L = (long)i * G + c; if (L >= nwg) return false;
        int wgid = (int)L; { const int q = nwg / NXCD, r = nwg % NXCD, xcd = wgid % NXCD, off = wgid / NXCD; wgid = (xcd < r ? xcd * (q + 1) : r * (q + 1) + (xcd - r) * q) + off; }
        const int nig = WGM * nN, gid = wgid / nig, fm = gid * WGM, gsz = (nM - fm) < WGM ? (nM - fm) : WGM;
        u.pm = fm + ((wgid % nig) % gsz); u.pn = (wgid % nig) / gsz; return true;
    }
    __device__ __forceinline__ void a_ready(const Unit&) const {}
    __device__ __forceinline__ void done(const Unit&) const {}
};

__device__ __forceinline__ unsigned cvt_pk_bf16(float lo, float hi) { unsigned r; asm volatile("v_cvt_pk_bf16_f32 %0, %1, %2" : "=v"(r) : "v"(lo), "v"(hi)); return r; }
typedef float f32x2 __attribute__((ext_vector_type(2)));
template <class Epi, class Sched, bool ALIGN_EPI = false, bool SP2 = false>
__device__ __forceinline__ void gemm_phase(PG8_LAS unsigned char* lds, const Gemm g, const Sched& S, const Epi& E) {
    const int tid = threadIdx.x, wid = __builtin_amdgcn_readfirstlane(tid >> 6), lane = tid & 63, wr = wid >> 2, wc = wid & 3, fr = lane & 15, fq = lane >> 4;
    const int K = g.K, nt = K / BK;
    unsigned voffA[2], voffB[2];
#pragma unroll
    for (int i = 0; i < 2; ++i) { int R, C; stage_rc(tid * 16 + i * 8192, R, C); const int Rb = Epi::PERM ? ((R & ~31) + perm32(R & 31)) : R;
        voffA[i] = (unsigned)(R * K + C) * 2u; voffB[i] = (unsigned)(Rb * K + C) * 2u; }
    const size_t kstep = (size_t)(BK * 2);
    const size_t hstep = (size_t)HALF * K * 2;
    const size_t tstep = 2 * hstep;
    const unsigned ldsw = (unsigned)wid * 1024u;
    const int aoff = lds_byte(wr * 64 + fr, fq * 8), boff = lds_byte(wc * 32 + fr, fq * 8);
#define PG8_SA(b, h) (((b) * 2 + (h)) * HTB)
#define PG8_SB(b, h) ((4 + (b) * 2 + (h)) * HTB)
#define PG8_STAGE(bufoff, gbase, voff) do { _Pragma("unroll") for (int _i = 0; _i < 2; ++_i) \
        __builtin_amdgcn_global_load_lds((const unsigned*)((const char*)(gbase) + (voff)[_i]), (PG8_LAS unsigned*)(lds + (bufoff) + ldsw + _i * 8192), 16, 0, 0); } while (0)
#define PG8_LDA(dst, b, h) do { _Pragma("unroll") for (int m = 0; m < 4; ++m) _Pragma("unroll") for (int k = 0; k < 2; ++k) dst[m][k] = *(const PG8_LAS bf16x8*)(lds + PG8_SA(b, h) + aoff + m * 2048 + k * 1024); } while (0)
#define PG8_LDB(dst, b, h) do { _Pragma("unroll") for (int n = 0; n < 2; ++n) _Pragma("unroll") for (int k = 0; k < 2; ++k) dst[n][k] = *(const PG8_LAS bf16x8*)(lds + PG8_SB(b, h) + boff + n * 2048 + k * 1024); } while (0)
#define PG8_MMA(ai, bj, At, Bt) do { __builtin_amdgcn_s_setprio(1); _Pragma("unroll") for (int m = 0; m < 4; ++m) _Pragma("unroll") for (int n = 0; n < 2; ++n) _Pragma("unroll") for (int k = 0; k < 2; ++k) \
        acc[ai][bj][m][n] = __builtin_amdgcn_mfma_f32_16x16x32_bf16(Bt[n][k], At[m][k], acc[ai][bj][m][n], 0, 0, 0); __builtin_amdgcn_s_setprio(0); } while (0)
#define PG8_WAIT_V(n) asm volatile("s_waitcnt vmcnt(" #n ")" ::: "memory")
#define PG8_WAIT_L(n) asm volatile("s_waitcnt lgkmcnt(" #n ")" ::: "memory")
#define PG8_BAR __builtin_amdgcn_s_barrier()
#define PG8_SCHED __builtin_amdgcn_sched_barrier(0)
    Unit cur, nxt; int ui = 0;
    if (!S.next(0, cur)) return;
    f32x4 acc[2][2][4][2];
#pragma unroll
    for (int a = 0; a < 2; ++a)
#pragma unroll
        for (int b = 0; b < 2; ++b)
#pragma unroll
            for (int m = 0; m < 4; ++m)
#pragma unroll
                for (int n = 0; n < 2; ++n) acc[a][b][m][n] = (f32x4){0.f, 0.f, 0.f, 0.f};
    bf16x8 At[4][2], B0[2][2], B1[2][2];
    const char* cA = (const char*)g.A + (size_t)cur.pm * tstep; const char* cB = (const char*)g.Bt + (size_t)cur.pn * tstep;
    S.a_ready(cur);
    if constexpr (SP2) {
        PG8_STAGE(PG8_SB(0, 0), cB, voffB); PG8_STAGE(PG8_SB(0, 1), cB + hstep, voffB); PG8_STAGE(PG8_SA(0, 0), cA, voffA); PG8_STAGE(PG8_SA(0, 1), cA + hstep, voffA);
        if (wr == 1) PG8_BAR;
        PG8_WAIT_V(2); PG8_BAR;
        PG8_STAGE(PG8_SB(1, 0), cB + kstep, voffB); PG8_STAGE(PG8_SA(1, 0), cA + kstep, voffA); PG8_STAGE(PG8_SB(1, 1), cB + hstep + kstep, voffB);
        PG8_WAIT_V(6); PG8_BAR;
    } else {
        PG8_STAGE(PG8_SB(0, 0), cB, voffB); PG8_STAGE(PG8_SA(0, 0), cA, voffA); PG8_STAGE(PG8_SB(0, 1), cB + hstep, voffB); PG8_STAGE(PG8_SA(0, 1), cA + hstep, voffA);
        if (wr == 1) PG8_BAR;
        PG8_WAIT_V(4); PG8_BAR;
        PG8_STAGE(PG8_SB(1, 0), cB + kstep, voffB); PG8_STAGE(PG8_SA(1, 0), cA + kstep, voffA); PG8_STAGE(PG8_SB(1, 1), cB + hstep + kstep, voffB);
        PG8_WAIT_V(6); PG8_BAR;
    }
    for (;;) {
        const bool has_next = S.next(ui + 1, nxt);
        const char* nA = has_next ? (const char*)g.A + (size_t)nxt.pm * tstep : cA; const char* nB = has_next ? (const char*)g.Bt + (size_t)nxt.pn * tstep : cB;
        for (int t = 0; t < nt; t += 2) {
            const bool last = (t == nt - 2);
            const char* a1 = cA + (size_t)(t + 1) * kstep;
            const char* a2 = last ? nA : cA + (size_t)(t + 2) * kstep; const char* b2 = last ? nB : cB + (size_t)(t + 2) * kstep;
            const char* a3 = a2 + kstep; const char* b3 = b2 + kstep;
            if (last && has_next) S.a_ready(nxt);
            if constexpr (SP2) {
            PG8_LDB(B0, 0, 0); PG8_LDB(B1, 0, 1); PG8_SCHED; PG8_LDA(At, 0, 0); PG8_STAGE(PG8_SA(1, 1), a1 + hstep, voffA);
            PG8_WAIT_V(8); PG8_WAIT_L(0); PG8_BAR; PG8_MMA(0, 0, At, B0); PG8_MMA(0, 1, At, B1); PG8_BAR; PG8_SCHED;
            PG8_LDA(At, 0, 1); PG8_STAGE(PG8_SB(0, 0), b2, voffB); PG8_STAGE(PG8_SB(0, 1), b2 + hstep, voffB); PG8_STAGE(PG8_SA(0, 0), a2, voffA);
            PG8_WAIT_V(8); PG8_WAIT_L(0); PG8_BAR; PG8_MMA(1, 0, At, B0); PG8_MMA(1, 1, At, B1); PG8_BAR; PG8_SCHED;
            PG8_LDB(B0, 1, 0); PG8_LDB(B1, 1, 1); PG8_SCHED; PG8_LDA(At, 1, 0); PG8_STAGE(PG8_SA(0, 1), a2 + hstep, voffA);
            PG8_WAIT_V(8); PG8_WAIT_L(0); PG8_BAR; PG8_MMA(0, 0, At, B0); PG8_MMA(0, 1, At, B1); PG8_BAR; PG8_SCHED;
            PG8_LDA(At, 1, 1); PG8_STAGE(PG8_SB(1, 0), b3, voffB); PG8_STAGE(PG8_SB(1, 1), b3 + hstep, voffB); PG8_STAGE(PG8_SA(1, 0), a3, voffA);
            PG8_WAIT_V(8); PG8_WAIT_L(0); PG8_BAR; PG8_MMA(1, 0, At, B0); PG8_MMA(1, 1, At, B1); PG8_BAR; PG8_SCHED;
            } else {
            PG8_LDB(B0, 0, 0); PG8_SCHED; PG8_LDA(At, 0, 0); PG8_STAGE(PG8_SA(1, 1), a1 + hstep, voffA);
            PG8_WAIT_L(8); PG8_BAR; PG8_WAIT_L(0); PG8_MMA(0, 0, At, B0); PG8_BAR; PG8_SCHED;
            PG8_LDB(B1, 0, 1); PG8_STAGE(PG8_SB(0, 0), b2, voffB);
            PG8_BAR; PG8_WAIT_L(0); PG8_MMA(0, 1, At, B1); PG8_BAR;
            PG8_LDA(At, 0, 1); PG8_STAGE(PG8_SA(0, 0), a2, voffA);
            PG8_BAR; PG8_WAIT_L(0); PG8_MMA(1, 0, At, B0); PG8_BAR; PG8_SCHED;
            PG8_STAGE(PG8_SB(0, 1), b2 + hstep, voffB);
            PG8_WAIT_V(6); PG8_BAR; PG8_MMA(1, 1, At, B1); PG8_BAR;
            PG8_LDB(B0, 1, 0); PG8_SCHED; PG8_LDA(At, 1, 0); PG8_STAGE(PG8_SA(0, 1), a2 + hstep, voffA);
            PG8_WAIT_L(8); PG8_BAR; PG8_WAIT_L(0); PG8_MMA(0, 0, At, B0); PG8_BAR; PG8_SCHED;
            PG8_LDB(B1, 1, 1); PG8_STAGE(PG8_SB(1, 0), b3, voffB);
            PG8_BAR; PG8_WAIT_L(0); PG8_MMA(0, 1, At, B1); PG8_BAR;
            PG8_LDA(At, 1, 1); PG8_STAGE(PG8_SA(1, 0), a3, voffA);
            PG8_BAR; PG8_WAIT_L(0); PG8_MMA(1, 0, At, B0); PG8_BAR; PG8_SCHED;
            PG8_STAGE(PG8_SB(1, 1), b3 + hstep, voffB);
            PG8_WAIT_V(6); PG8_BAR; PG8_MMA(1, 1, At, B1); PG8_BAR;
            }
        }
        if constexpr (ALIGN_EPI) { if (wr == 0) PG8_BAR; }
        if constexpr (!Epi::AFTER_DRAIN) { E(acc, cur, wr, wc, fr, fq); S.done(cur); }
        if (!has_next) break;
#pragma unroll
        for (int a = 0; a < 2; ++a)
#pragma unroll
            for (int b = 0; b < 2; ++b)
#pragma unroll
                for (int m = 0; m < 4; ++m)
#pragma unroll
                    for (int n = 0; n < 2; ++n) acc[a][b][m][n] = (f32x4){0.f, 0.f, 0.f, 0.f};
        cur = nxt; cA = nA; cB = nB; ++ui;
        if constexpr (ALIGN_EPI) { if (wr == 1) PG8_BAR; }
    }
    PG8_WAIT_V(0);
    if constexpr (!ALIGN_EPI) { if (wr == 0) PG8_BAR; }
    PG8_BAR;
    if constexpr (Epi::AFTER_DRAIN) { E.fused(acc, cur, wr, wc, fr, fq, lds, wid, lane); S.done(cur); }
#undef PG8_SA
#undef PG8_SB
#undef PG8_STAGE
#undef PG8_LDA
#undef PG8_LDB
#undef PG8_MMA
#undef PG8_WAIT_V
#undef PG8_WAIT_L
#undef PG8_BAR
#undef PG8_SCHED
}
}
constexpr int NWAVES = 8;
constexpr int NB = 4, SEQ = 4096, D = 1024, M = NB * SEQ;
constexpr int NH = 4, VD = 128, AW = 512, CWID = 512, CK = 31;
constexpr int NCOL = 4608;
constexpr int NE = 64, DE = 512;
constexpr float EPS = 1e-6f;
constexpr float LOG2E = 1.4426950408889634f;
constexpr float QSCALE = 0.125f * LOG2E;
constexpr int MAXTILES = 192;
constexpr int NPHASE = 10;

constexpr size_t MiB = 1u << 20;
constexpr size_t WS_CTL = 0, CTL_ZERO_BYTES = 1 * MiB;
constexpr size_t WS_WRF = 1 * MiB;
constexpr size_t WS_TOKINFO = 2 * MiB;
constexpr size_t WS_TOKSLOT = 2 * MiB + 512 * 1024;
constexpr size_t WS_ROWW = 2 * MiB + 768 * 1024;
constexpr size_t WS_WIN = 4 * MiB;
constexpr size_t WS_WMIX = 13 * MiB;
constexpr size_t WS_WOUT = 15 * MiB;
constexpr size_t WS_WGU = 17 * MiB;
constexpr size_t WS_WD = 145 * MiB;
constexpr size_t WS_B = 209 * MiB;
constexpr size_t WS_XN = WS_B + 0 * MiB;
constexpr size_t WS_Q = WS_B + 32 * MiB;
constexpr size_t WS_K = WS_B + 48 * MiB;
constexpr size_t WS_V = WS_B + 64 * MiB;
constexpr size_t WS_U = WS_B + 80 * MiB;
constexpr size_t WS_G = WS_B + 96 * MiB;
constexpr size_t WS_AO = WS_B + 160 * MiB;
constexpr size_t WS_UC = WS_B + 176 * MiB;
constexpr size_t WS_MG = WS_B + 192 * MiB;
constexpr size_t WS_T = WS_B + 0 * MiB;
constexpr size_t WS_XG = WS_B + 0 * MiB;
constexpr size_t WS_ACT = WS_B + 96 * MiB;
constexpr size_t WS_Y = WS_B + 144 * MiB;
constexpr size_t WS_END = WS_B + 240 * MiB;
constexpr int CW_BAR = 4096;
constexpr int CW_GCNT = 8192;

constexpr int RING_OFF = 0, RING_BYTES = 131072;
constexpr int LDSCTL_OFF = 155648;
constexpr int ATT_TAB_OFF = LDSCTL_OFF + 512;
constexpr int MOE_TAB_OFF = LDSCTL_OFF + 4096;
constexpr int LDS_BYTES = 163840;

#define GAS __attribute__((address_space(1)))
#define LAS __attribute__((address_space(3)))
typedef unsigned short bf16;
typedef unsigned v4u __attribute__((ext_vector_type(4)));
typedef unsigned v2u __attribute__((ext_vector_type(2)));
typedef float f32x4 __attribute__((ext_vector_type(4)));
typedef float f32x16 __attribute__((ext_vector_type(16)));
typedef short bf16x8 __attribute__((ext_vector_type(8)));
typedef short s16x4 __attribute__((ext_vector_type(4)));
typedef GAS unsigned gu32;
#define RLX_AGENT __ATOMIC_RELAXED, __HIP_MEMORY_SCOPE_AGENT
#define LDS_WAIT() asm volatile("s_waitcnt lgkmcnt(0)" ::: "memory")
#define VM_WAIT() asm volatile("s_waitcnt vmcnt(0)" ::: "memory")
typedef float f32x2_t __attribute__((ext_vector_type(2)));
typedef __bf16 bf16x2_t __attribute__((ext_vector_type(2)));
__device__ __forceinline__ unsigned pk2(float lo, float hi) { f32x2_t v = {lo, hi}; bf16x2_t b = __builtin_convertvector(v, bf16x2_t); return __builtin_bit_cast(unsigned, b); }
__device__ __forceinline__ float bf2f(unsigned short h) { return __uint_as_float((unsigned)h << 16); }
__device__ __forceinline__ float bflo(unsigned w) { return __uint_as_float(w << 16); }
__device__ __forceinline__ float bfhi(unsigned w) { return __uint_as_float(w & 0xffff0000u); }
__device__ __forceinline__ float sigmoidf_(float x) { return __builtin_amdgcn_rcpf(1.f + __expf(-x)); }
__device__ __forceinline__ float wave_sum(float v) {
#pragma unroll
    for (int o = 1; o < 64; o <<= 1) v += __shfl_xor(v, o);
    return v;
}
__device__ __forceinline__ float xhalf_max(float a) { auto rr = __builtin_amdgcn_permlane32_swap(__float_as_uint(a), __float_as_uint(a), false, false); return fmaxf(__uint_as_float(rr[0]), __uint_as_float(rr[1])); }
__device__ __forceinline__ float xhalf_sum(float a) { auto rr = __builtin_amdgcn_permlane32_swap(__float_as_uint(a), __float_as_uint(a), false, false); return __uint_as_float(rr[0]) + __uint_as_float(rr[1]); }
__device__ __forceinline__ int crow(int r, int hi) { return (r & 3) + 8 * (r >> 2) + 4 * hi; }

#define XB_TMO      128
#define XB_XCNT(j)  (256  + 64 * (j))
#define XB_XSUB(j)  (1280 + 64 * (j))
#define XB_XGEN(j)  (2304 + 64 * (j))
#define XB_TOP      3328
#define XB_TOPGEN   3392
#define XCD_BAR_WORDS 3456
#define XB_SPIN_CAP (1u << 18)

__device__ __forceinline__ unsigned xb_ld(unsigned* p)              { return __hip_atomic_load(p, __ATOMIC_RELAXED, __HIP_MEMORY_SCOPE_AGENT); }
__device__ __forceinline__ unsigned xb_add(unsigned* p, unsigned v) { return __hip_atomic_fetch_add(p, v, __ATOMIC_RELAXED, __HIP_MEMORY_SCOPE_AGENT); }
__device__ __forceinline__ unsigned xb_xcc_id() { return (unsigned)__builtin_amdgcn_s_getreg((3 << 11) | 20) & 0xFu; }
#define XB_SPIN(cond, bar) do { unsigned _sp = 0; while (cond) { __builtin_amdgcn_s_sleep(1); \
    if ((++_sp & 255u) == 0u) { if (xb_ld(&(bar)[XB_TMO])) break; if (_sp > XB_SPIN_CAP) { atomicAdd(&(bar)[XB_TMO], 1u); break; } } } } while (0)

struct XcdBarrier {
    unsigned* bar; unsigned x;
    volatile LAS unsigned* st;
};

__device__ __forceinline__ XcdBarrier xcd_barrier_post(unsigned* bar, volatile LAS unsigned* st) {
    XcdBarrier b; b.bar = bar; b.x = xb_xcc_id(); b.st = st;
    if (threadIdx.x == 0) (void)xb_add(&bar[XB_XCNT(b.x)], 1u);
    return b;
}
__device__ __forceinline__ void xcd_barrier_complete(unsigned* bar, unsigned x, unsigned& nloc, unsigned& nx) {
    const unsigned G = gridDim.x * gridDim.y * gridDim.z;
    unsigned sum, cnt, mine, sp = 0u;
    for (;;) {
        sum = 0u; cnt = 0u; mine = 0u;
#pragma unroll
        for (unsigned j = 0; j < 16; ++j) { const unsigned c = xb_ld(&bar[XB_XCNT(j)]); sum += c; cnt += (c > 0u) ? 1u : 0u; mine = (j == x) ? c : mine; }
        if (sum == G) break;
        __builtin_amdgcn_s_sleep(1);
        if ((++sp & 255u) == 0u) { if (xb_ld(&bar[XB_TMO])) break; if (sp > XB_SPIN_CAP) { atomicAdd(&bar[XB_TMO], 1u); break; } }
    }
    nloc = mine > 0u ? mine : 1u; nx = cnt > 0u ? cnt : 1u;
}

__device__ __forceinline__ void xcd_barrier(const XcdBarrier& b) {
    asm volatile("s_waitcnt vmcnt(0)" ::: "memory");
    __syncthreads();
    if (threadIdx.x == 0) {
        unsigned* bar = b.bar;
        __builtin_amdgcn_s_waitcnt(0);
        unsigned nloc = b.st[0], nx = b.st[1];
        if (nloc == 0u) { xcd_barrier_complete(bar, b.x, nloc, nx); b.st[0] = nloc; b.st[1] = nx; }
        const unsigned old = xb_add(&bar[XB_XSUB(b.x)], 1u);
        const unsigned gen = old / nloc;
        if (old + 1u == (gen + 1u) * nloc) {
            __builtin_amdgcn_fence(__ATOMIC_RELEASE, "agent");
            asm volatile("s_waitcnt vmcnt(0)" ::: "memory");
            const unsigned og = xb_add(&bar[XB_TOP], 1u);
            const unsigned tg = og / nx;
            if (og + 1u == (tg + 1u) * nx) xb_add(&bar[XB_TOPGEN], 1u);
            else XB_SPIN(xb_ld(&bar[XB_TOPGEN]) == tg, bar);
            __builtin_amdgcn_fence(__ATOMIC_ACQUIRE, "agent");
            xb_add(&bar[XB_XGEN(b.x)], 1u);
            asm volatile("s_waitcnt vmcnt(0)" ::: "memory");
        } else {
            XB_SPIN(xb_ld(&bar[XB_XGEN(b.x)]) == gen, bar);
            __builtin_amdgcn_fence(__ATOMIC_ACQUIRE, "agent");
            asm volatile("s_waitcnt vmcnt(0)" ::: "memory");
        }
    }
    __syncthreads();
}
#ifndef XP_IN_ATTN
#define XP_IN_ATTN 1
#endif

struct Frame {
    LAS unsigned char* lds;
    gu32* ctl;
    int tid, lane, wave;
    int vcu, G;
    const float *x, *w_in, *lq1, *lk1, *lq2, *lk2, *gsub, *relb, *w_au, *w_dw, *b_dw, *g_cln, *b_cln, *w_pw, *b_pw, *w_out, *g_mix, *g_ffn,
                *w_rg, *b_rg, *w_re, *b_re, *w_eg, *w_eu, *w_ed, *g_fin;
    float* out;
    bf16 *Win_t, *Wmix_t, *Wout_t, *Wgu_t, *Wd_t;
    bf16 *XN, *Qb, *Kb, *Vb, *U, *Gt, *AO, *UC, *MG, *XG, *ACT, *Y;
    float *T, *Wrf, *roww;
    int *tokinfo, *tokslot;
};

__device__ __forceinline__ int win_src_col(int pc) {
    if (pc < 1536 || pc >= 2560) return pc;
    const int t = (pc - 1536) >> 8, w = (pc - 1536) & 255, bj = w >> 7, i = w & 127;
    return 1536 + bj * 512 + t * 128 + i;
}
__device__ __forceinline__ void tr_tile(const float* src, int ldn, int k0, int c0, bf16* dst, int K, size_t r0, LAS unsigned* scr, int lane) {
    const int n4 = (lane & 15) * 4, kr = lane >> 4;
    f32x4 a[8], b[8];
#pragma unroll
    for (int i = 0; i < 8; ++i) { const int kp = 4 * i + kr;
        a[i] = *(const GAS f32x4*)(src + (size_t)(k0 + 2 * kp) * ldn + c0 + n4);
        b[i] = *(const GAS f32x4*)(src + (size_t)(k0 + 2 * kp + 1) * ldn + c0 + n4); }
#pragma unroll
    for (int i = 0; i < 8; ++i) { const int kp = 4 * i + kr;
        scr[(n4 + 0) * 33 + kp] = pk2(a[i].x, b[i].x); scr[(n4 + 1) * 33 + kp] = pk2(a[i].y, b[i].y);
        scr[(n4 + 2) * 33 + kp] = pk2(a[i].z, b[i].z); scr[(n4 + 3) * 33 + kp] = pk2(a[i].w, b[i].w); }
    LDS_WAIT(); asm volatile("" ::: "memory");
#pragma unroll
    for (int jj = 0; jj < 8; ++jj) { const int n = (lane >> 3) + 8 * jj, ch = lane & 7;
        v4u o; o.x = scr[n * 33 + ch * 4 + 0]; o.y = scr[n * 33 + ch * 4 + 1]; o.z = scr[n * 33 + ch * 4 + 2]; o.w = scr[n * 33 + ch * 4 + 3];
        *(GAS v4u*)(dst + (r0 + n) * (size_t)K + k0 + ch * 8) = o; }
    LDS_WAIT(); asm volatile("" ::: "memory");
}
__device__ __forceinline__ void p0_prologue(Frame& F) {
    LAS unsigned* scr = (LAS unsigned*)(F.lds + RING_OFF + F.wave * 8704);
    const int gw = F.vcu * NWAVES + F.wave, NGW = F.G * NWAVES, lane = F.lane;
    constexpr int I_IN = 16 * 72, I_AU = 8 * 16, I_PW = 8 * 16, I_OUT = 16 * 16, I_EXP = 384;
    constexpr int NITEMS = I_IN + I_AU + I_PW + I_OUT + (XP_IN_ATTN ? 0 : NE * I_EXP);
    for (int it = gw; it < NITEMS; it += NGW) {
        int r = it;
        if (r < I_IN) { const int kt = r / 72, rt = r % 72; tr_tile(F.w_in, NCOL, kt * 64, win_src_col(rt * 64), F.Win_t, 1024, (size_t)rt * 64, scr, lane); continue; } r -= I_IN;
        if (r < I_AU) { const int kt = r / 16, rt = r % 16; tr_tile(F.w_au, 1024, kt * 64, rt * 64, F.Wmix_t, 512, (size_t)rt * 64, scr, lane); continue; } r -= I_AU;
        if (r < I_PW) { const int kt = r / 16, rt = r % 16; tr_tile(F.w_pw, 1024, kt * 64, rt * 64, F.Wmix_t, 512, (size_t)1024 + rt * 64, scr, lane); continue; } r -= I_PW;
        if (r < I_OUT) { const int kt = r / 16, rt = r % 16; tr_tile(F.w_out, 1024, kt * 64, rt * 64, F.Wout_t, 1024, (size_t)rt * 64, scr, lane); continue; } r -= I_OUT;
        const int e = r / I_EXP; r -= e * I_EXP;
        if (r < 256) {
            const int bj = r >> 7, q = r & 127, kt = q >> 3, ct = q & 7, c0 = ct * 64;
            const float* src = (bj ? F.w_eu : F.w_eg) + (size_t)e * 1024 * 512;
            tr_tile(src, 512, kt * 64, c0, F.Wgu_t, 1024, (size_t)e * 1024 + (c0 >> 7) * 256 + bj * 128 + (c0 & 127), scr, lane);
        } else {
            const int q = r - 256, kt = q >> 4, ct = q & 15;
            tr_tile(F.w_ed + (size_t)e * 512 * 1024, 1024, kt * 64, ct * 64, F.Wd_t, 512, (size_t)e * 1024 + ct * 64, scr, lane);
        }
    }
    for (int m = gw; m < M; m += NGW) {
        const GAS f32x4* xr = (const GAS f32x4*)(F.x + (size_t)m * D) + lane; const GAS f32x4* gr = (const GAS f32x4*)F.g_mix + lane;
        f32x4 v[4]; float s = 0.f;
#pragma unroll
        for (int j = 0; j < 4; ++j) { v[j] = xr[64 * j]; s += (v[j].x * v[j].x + v[j].y * v[j].y) + (v[j].z * v[j].z + v[j].w * v[j].w); }
        const float rs = rsqrtf(wave_sum(s) * (1.f / D) + EPS);
        GAS v2u* o8 = (GAS v2u*)(F.XN + (size_t)m * D) + lane;
#pragma unroll
        for (int j = 0; j < 4; ++j) { const f32x4 g = gr[64 * j]; v2u o; o.x = pk2(v[j].x * rs * g.x, v[j].y * rs * g.y); o.y = pk2(v[j].z * rs * g.z, v[j].w * rs * g.w); o8[64 * j] = o; }
    }
    for (int i = F.vcu * 512 + F.tid; i < 64 * 5 * 64 * 4; i += F.G * 512) {
        const int j = i & 3, l = (i >> 2) & 63, q = i >> 8, ct = q % 5, kc = q / 5;
        const int k = kc * 16 + 4 * (l >> 4) + j, c = ct * 16 + (l & 15);
        float wv = 0.f; if (c < 8) wv = F.w_rg[k * 8 + c]; else if (c < 72) wv = F.w_re[k * 64 + (c - 8)];
        F.Wrf[i] = wv * F.g_ffn[k];
    }
}

using pg8::Unit;
struct EpiProj {
    static constexpr bool PERM = true, AFTER_DRAIN = false;
    bf16 *Q, *K, *V, *U, *G;
    __device__ __forceinline__ void operator()(const f32x4 (&acc)[2][2][4][2], const Unit& u, int wr, int wc, int fr, int fq) const {
        int row0 = u.pm * 256 + wr * 64 + fr; const int pn = u.pn;
        asm volatile("" : "+v"(row0), "+v"(fq));
        if (pn < 6) {
            bf16* base = Q + (size_t)(pn >> 1) * ((size_t)M * 512); const float sc = pn < 2 ? QSCALE : 1.f;
            const int col0 = (pn & 1) * 256 + wc * 32 + 8 * fq;
#pragma unroll
            for (int ai = 0; ai < 2; ++ai)
#pragma unroll
                for (int m = 0; m < 4; ++m) { bf16* rowp = base + (size_t)(row0 + ai * 128 + m * 16) * 512 + col0;
#pragma unroll
                    for (int bj = 0; bj < 2; ++bj) { const f32x4 v0 = acc[ai][bj][m][0] * sc, v1 = acc[ai][bj][m][1] * sc; v4u w;
                        w.x = pk2(v0[0], v0[1]); w.y = pk2(v0[2], v0[3]); w.z = pk2(v1[0], v1[1]); w.w = pk2(v1[2], v1[3]);
                        *(v4u*)(rowp + bj * 128) = w; } }
        } else if (pn < 10) {
            const int col0 = (pn - 6) * 128 + wc * 32 + 8 * fq;
#pragma unroll
            for (int ai = 0; ai < 2; ++ai)
#pragma unroll
                for (int m = 0; m < 4; ++m) { bf16* rowp = U + (size_t)(row0 + ai * 128 + m * 16) * 512 + col0;
                    const f32x4 a0 = acc[ai][0][m][0], a1 = acc[ai][0][m][1], b0 = acc[ai][1][m][0], b1 = acc[ai][1][m][1]; v4u w;
                    w.x = pk2(a0[0] * sigmoidf_(b0[0]), a0[1] * sigmoidf_(b0[1])); w.y = pk2(a0[2] * sigmoidf_(b0[2]), a0[3] * sigmoidf_(b0[3]));
                    w.z = pk2(a1[0] * sigmoidf_(b1[0]), a1[1] * sigmoidf_(b1[1])); w.w = pk2(a1[2] * sigmoidf_(b1[2]), a1[3] * sigmoidf_(b1[3]));
                    *(v4u*)rowp = w; }
        } else {
            const int col0 = (pn - 10) * 256 + wc * 32 + 8 * fq;
#pragma unroll
            for (int ai = 0; ai < 2; ++ai)
#pragma unroll
                for (int m = 0; m < 4; ++m) { bf16* rowp = G + (size_t)(row0 + ai * 128 + m * 16) * 2048 + col0;
#pragma unroll
                    for (int bj = 0; bj < 2; ++bj) { const f32x4 v0 = acc[ai][bj][m][0], v1 = acc[ai][bj][m][1]; v4u w;
                        w.x = pk2(sigmoidf_(v0[0]), sigmoidf_(v0[1])); w.y = pk2(sigmoidf_(v0[2]), sigmoidf_(v0[3]));
                        w.z = pk2(sigmoidf_(v1[0]), sigmoidf_(v1[1])); w.w = pk2(sigmoidf_(v1[2]), sigmoidf_(v1[3]));
                        *(v4u*)(rowp + bj * 128) = w; } }
        }
    }
};
struct EpiMerge {
    static constexpr bool PERM = true, AFTER_DRAIN = false;
    const bf16* G; const float* bpw; float* Tw; bf16* MG;
    __device__ __forceinline__ void operator()(const f32x4 (&acc)[2][2][4][2], const Unit& u, int wr, int wc, int fr, int fq) const {
        const bool sub = u.pm >= 64; const int pm = u.pm & 63, pn = u.pn & 3;
        int row0 = pm * 256 + wr * 64 + fr, col0 = pn * 256 + wc * 32 + 8 * fq, tix = threadIdx.x;
        asm volatile("" : "+v"(row0), "+v"(col0), "+v"(tix));
#ifdef DBG_SIMPLE_MERGE
#ifdef DBG_DELAY
        if (!sub) { const unsigned long long t0_ = __builtin_amdgcn_s_memrealtime(); while (__builtin_amdgcn_s_memrealtime() - t0_ < 2000ull) __builtin_amdgcn_s_sleep(4); }
#endif
#ifdef DBG_GLOAD
        float gsum = 0.f;
        if (!sub) {
#pragma unroll
            for (int ai = 0; ai < 2; ++ai)
#pragma unroll
                for (int m = 0; m < 4; ++m) { const bf16* gp = G + (size_t)(row0 + ai * 128 + m * 16) * 2048 + col0; const v4u g = *(const v4u*)gp; gsum += bflo(g.x) + bflo(g.w); asm volatile("" ::: "memory"); }
            if (gsum == 12345.678f) MG[0] = 1;
        }
#endif
        if (sub) {
#pragma unroll
            for (int ai = 0; ai < 2; ++ai)
#pragma unroll
                for (int m = 0; m < 4; ++m) { bf16* op = MG + (size_t)(row0 + ai * 128 + m * 16) * 1024 + col0;
#pragma unroll
                    for (int bj = 0; bj < 2; ++bj) { const f32x4 v0 = acc[ai][bj][m][0], v1 = acc[ai][bj][m][1]; v4u w;
                        w.x = pk2(v0[0], v0[1]); w.y = pk2(v0[2], v0[3]); w.z = pk2(v1[0], v1[1]); w.w = pk2(v1[2], v1[3]);
                        *(v4u*)(op + bj * 128) = w; } }
        }
        return;
#endif
        f32x4* tp = (f32x4*)Tw + (size_t)tix * 4;
        if (!sub) {
#pragma unroll
            for (int ai = 0; ai < 2; ++ai)
#pragma unroll
                for (int m = 0; m < 4; ++m) { const bf16* gp = G + (size_t)(row0 + ai * 128 + m * 16) * 2048 + col0;
#pragma unroll
                    for (int bj = 0; bj < 2; ++bj) { const v4u g = *(const v4u*)(gp + bj * 128); const f32x4 v0 = acc[ai][bj][m][0], v1 = acc[ai][bj][m][1];
                        f32x4* tg = tp + (size_t)(ai * 4 + m) * 2048 + bj * 2;
#ifndef DBG_NO_TSTORE
                        tg[0] = (f32x4){v0[0] * bflo(g.x), v0[1] * bfhi(g.x), v0[2] * bflo(g.y), v0[3] * bfhi(g.y)};
                        tg[1] = (f32x4){v1[0] * bflo(g.z), v1[1] * bfhi(g.z), v1[2] * bflo(g.w), v1[3] * bfhi(g.w)};
#else
                        if (v0[0] * bflo(g.x) + v1[3] * bfhi(g.w) == 12345.678f) tg[0] = v0;
#endif
                        }
                    }
        } else {
            f32x4 bv[2][2];
#pragma unroll
            for (int bj = 0; bj < 2; ++bj) { bv[bj][0] = *(const f32x4*)(bpw + col0 + bj * 128); bv[bj][1] = *(const f32x4*)(bpw + col0 + bj * 128 + 4); }
#pragma unroll
            for (int ai = 0; ai < 2; ++ai)
#pragma unroll
                for (int m = 0; m < 4; ++m) { const size_t rr = (size_t)(row0 + ai * 128 + m * 16); const bf16* gp = G + rr * 2048 + 1024 + col0; bf16* op = MG + rr * 1024 + col0;
#pragma unroll
                    for (int bj = 0; bj < 2; ++bj) { const v4u g = *(const v4u*)(gp + bj * 128); const f32x4 v0 = acc[ai][bj][m][0] + bv[bj][0], v1 = acc[ai][bj][m][1] + bv[bj][1];
                        const f32x4* tg = tp + (size_t)(ai * 4 + m) * 2048 + bj * 2; f32x4 t0 = tg[0], t1 = tg[1]; v4u w;
#ifdef DBG_NO_T
                        t0 = (f32x4){0.f, 0.f, 0.f, 0.f}; t1 = t0;
#endif
                        w.x = pk2(t0[0] + v0[0] * bflo(g.x), t0[1] + v0[1] * bfhi(g.x)); w.y = pk2(t0[2] + v0[2] * bflo(g.y), t0[3] + v0[3] * bfhi(g.y));
                        w.z = pk2(t1[0] + v1[0] * bflo(g.z), t1[1] + v1[1] * bfhi(g.z)); w.w = pk2(t1[2] + v1[2] * bflo(g.w), t1[3] + v1[3] * bfhi(g.w));
                        *(v4u*)(op + bj * 128) = w;
#ifdef DBG_ACCOUT
                        { const f32x4 r0 = acc[ai][bj][m][0], r1 = acc[ai][bj][m][1]; v4u w2; w2.x = pk2(r0[0], r0[1]); w2.y = pk2(r0[2], r0[3]); w2.z = pk2(r1[0], r1[1]); w2.w = pk2(r1[2], r1[3]);
                          *(v4u*)(op + ((size_t)(450 - 209 - 192) << 20) / 2 + bj * 128) = w2; }
#endif
                        }
                    }
        }
    }
};
struct PairOrder {
    pg8::StaticOrder so;
    __device__ __forceinline__ bool next(int i, Unit& u) const { Unit b; if (!so.next(i >> 1, b)) return false; const int sub = i & 1; u.pm = b.pm + 64 * sub; u.pn = b.pn + 4 * sub; return true; }
    __device__ __forceinline__ void a_ready(const Unit&) const {}
    __device__ __forceinline__ void done(const Unit&) const {}
};
struct EpiX1 {
    static constexpr bool PERM = false, AFTER_DRAIN = false;
    const float* X; float* O;
    __device__ __forceinline__ void operator()(const f32x4 (&acc)[2][2][4][2], const Unit& u, int wr, int wc, int fr, int fq) const {
        int row0 = u.pm * 256 + wr * 64 + fr, col0 = u.pn * 256 + wc * 32 + 4 * fq;
        asm volatile("" : "+v"(row0), "+v"(col0));
#pragma unroll
        for (int ai = 0; ai < 2; ++ai)
#pragma unroll
            for (int m = 0; m < 4; ++m) { const size_t off = (size_t)(row0 + ai * 128 + m * 16) * D + col0;
#pragma unroll
                for (int bj = 0; bj < 2; ++bj)
#pragma unroll
                    for (int n = 0; n < 2; ++n) { const f32x4 xv = *(const f32x4*)(X + off + bj * 128 + n * 16); *(f32x4*)(O + off + bj * 128 + n * 16) = xv + acc[ai][bj][m][n]; } }
    }
};
struct EpiSwiglu {
    static constexpr bool PERM = true, AFTER_DRAIN = false;
    bf16* ACT;
    __device__ __forceinline__ void operator()(const f32x4 (&acc)[2][2][4][2], const Unit& u, int wr, int wc, int fr, int fq) const {
        int row0 = u.pm * 256 + wr * 64 + fr, col0 = (u.pn & 3) * 128 + wc * 32 + 8 * fq;
        asm volatile("" : "+v"(row0), "+v"(col0));
#pragma unroll
        for (int ai = 0; ai < 2; ++ai)
#pragma unroll
            for (int m = 0; m < 4; ++m) { bf16* rowp = ACT + (size_t)(row0 + ai * 128 + m * 16) * 512 + col0;
                const f32x4 a0 = acc[ai][0][m][0], a1 = acc[ai][0][m][1], b0 = acc[ai][1][m][0], b1 = acc[ai][1][m][1]; v4u w;
                w.x = pk2(a0[0] * sigmoidf_(a0[0]) * b0[0], a0[1] * sigmoidf_(a0[1]) * b0[1]); w.y = pk2(a0[2] * sigmoidf_(a0[2]) * b0[2], a0[3] * sigmoidf_(a0[3]) * b0[3]);
                w.z = pk2(a1[0] * sigmoidf_(a1[0]) * b1[0], a1[1] * sigmoidf_(a1[1]) * b1[1]); w.w = pk2(a1[2] * sigmoidf_(a1[2]) * b1[2], a1[3] * sigmoidf_(a1[3]) * b1[3]);
                *(v4u*)rowp = w; }
    }
};
struct EpiDown {
    static constexpr bool PERM = true, AFTER_DRAIN = false;
    bf16* Y; const float* roww;
    __device__ __forceinline__ void operator()(const f32x4 (&acc)[2][2][4][2], const Unit& u, int wr, int wc, int fr, int fq) const {
        int row0 = u.pm * 256 + wr * 64 + fr, col0 = (u.pn & 3) * 256 + wc * 32 + 8 * fq;
        asm volatile("" : "+v"(row0), "+v"(col0));
#pragma unroll
        for (int ai = 0; ai < 2; ++ai)
#pragma unroll
            for (int m = 0; m < 4; ++m) { const int rr = row0 + ai * 128 + m * 16; const float sc = roww[rr]; bf16* rowp = Y + (size_t)rr * 1024 + col0;
#pragma unroll
                for (int bj = 0; bj < 2; ++bj) { const f32x4 v0 = acc[ai][bj][m][0] * sc, v1 = acc[ai][bj][m][1] * sc; v4u w;
                    w.x = pk2(v0[0], v0[1]); w.y = pk2(v0[2], v0[3]); w.z = pk2(v1[0], v1[1]); w.w = pk2(v1[2], v1[3]);
                    *(v4u*)(rowp + bj * 128) = w; } }
    }
};
struct MoeOrder {
    const LAS int* te; int ntile, G, c;
    __device__ __forceinline__ bool next(int i, Unit& u) const { const int L = i * G + c; if (L >= ntile * 4) return false; const int mt = L >> 2; u.pm = mt; u.pn = te[mt] * 4 + (L & 3); return true; }
    __device__ __forceinline__ void a_ready(const Unit&) const {}
    __device__ __forceinline__ void done(const Unit&) const {}
};
__device__ __forceinline__ void moe_tables(Frame& F) {
    LAS int* tab = (LAS int*)(F.lds + MOE_TAB_OFF);
    __syncthreads();
    if (F.tid < NE) tab[F.tid] = (int)__hip_atomic_load(F.ctl + CW_GCNT + 64 * F.tid, RLX_AGENT);
    __syncthreads();
    if (F.tid == 0) { int pt = 0;
        for (int e = 0; e < NE; ++e) { tab[64 + e] = pt; const int nt = (tab[e] + 255) >> 8; for (int k = 0; k < nt; ++k) tab[129 + pt + k] = e; pt += nt; }
        tab[64 + NE] = pt; tab[129 + MAXTILES] = pt; }
    __syncthreads();
}

__device__ __forceinline__ void conv_unit(Frame& F, int unit) {
    LAS unsigned char* lds = F.lds + RING_OFF;
    const int tid = F.tid, lane = F.lane, w = F.wave;
    const int row0 = unit * 32, b = row0 / SEQ, t0 = row0 % SEQ;
#pragma unroll 1
    for (int hb = 0; hb < 2; ++hb) {   v4u sv[4];
#pragma unroll
        for (int it = 0; it < 4; ++it) { int p = tid + (hb * 4 + it) * 512; p = p < 62 * 64 ? p : 62 * 64 - 1; const int r = p >> 6, ch = p & 63; int t = t0 - 30 + r; t = t < 0 ? 0 : t;
            sv[it] = *(const GAS v4u*)(F.U + ((size_t)b * SEQ + t) * 512 + ch * 8); }
#pragma unroll
        for (int it = 0; it < 4; ++it) { const int p = tid + (hb * 4 + it) * 512; const int r = p >> 6, ch = p & 63; const int t = t0 - 30 + r;
            if (p < 62 * 64) *(LAS v4u*)(lds + r * 1024 + ch * 16) = t >= 0 ? sv[it] : (v4u){0u, 0u, 0u, 0u}; } }
    __syncthreads();
    {
        typedef float f32x2v __attribute__((ext_vector_type(2)));
        const int cp = tid & 255, rh = tid >> 8;
        f32x2v wt[CK];
#pragma unroll
        for (int j = 0; j < CK; ++j) wt[j] = *(const GAS f32x2v*)(F.w_dw + j * 512 + 2 * cp);
        const f32x2v bias = *(const GAS f32x2v*)(F.b_dw + 2 * cp);
        f32x2v a[16];
#pragma unroll
        for (int r = 0; r < 16; ++r) a[r] = bias;
        const LAS unsigned* in = (const LAS unsigned*)lds + (rh * 16) * 256 + cp;
#pragma unroll
        for (int i = 0; i < 46; ++i) { const unsigned xw = in[i * 256]; const f32x2v xv = (f32x2v){bflo(xw), bfhi(xw)};
#pragma unroll
            for (int r = 0; r < 16; ++r) { if (i - r >= 0 && i - r < CK) a[r] += wt[i - r] * xv; } }
        LAS f32x2v* yo = (LAS f32x2v*)(lds + 63488) + (rh * 16) * 256 + cp;
#pragma unroll
        for (int r = 0; r < 16; ++r) yo[r * 256] = a[r]; }
    __syncthreads();
    {   const f32x4 g0 = *(const GAS f32x4*)(F.g_cln + lane * 8), g1 = *(const GAS f32x4*)(F.g_cln + lane * 8 + 4), b0 = *(const GAS f32x4*)(F.b_cln + lane * 8), b1 = *(const GAS f32x4*)(F.b_cln + lane * 8 + 4);
#pragma unroll
        for (int k = 0; k < 4; ++k) { const int r = w * 4 + k; const LAS f32x4* yp = (const LAS f32x4*)(lds + 63488 + r * 2048) + lane * 2;
            f32x4 v0 = yp[0], v1 = yp[1];
            const float mean = wave_sum((v0.x + v0.y) + (v0.z + v0.w) + (v1.x + v1.y) + (v1.z + v1.w)) * (1.f / 512.f);
            v0 = v0 - mean; v1 = v1 - mean;
            const float var = wave_sum((v0.x * v0.x + v0.y * v0.y) + (v0.z * v0.z + v0.w * v0.w) + (v1.x * v1.x + v1.y * v1.y) + (v1.z * v1.z + v1.w * v1.w)) * (1.f / 512.f);
            const float rs = rsqrtf(var + EPS);
            v0 = v0 * rs * g0 + b0; v1 = v1 * rs * g1 + b1;
            v4u o; o.x = pk2(v0.x * sigmoidf_(v0.x), v0.y * sigmoidf_(v0.y)); o.y = pk2(v0.z * sigmoidf_(v0.z), v0.w * sigmoidf_(v0.w));
            o.z = pk2(v1.x * sigmoidf_(v1.x), v1.y * sigmoidf_(v1.y)); o.w = pk2(v1.z * sigmoidf_(v1.z), v1.w * sigmoidf_(v1.w));
            *(GAS v4u*)(F.UC + (size_t)(row0 + r) * 512 + lane * 8) = o; } }
    __syncthreads();
}

constexpr int XP_TILES = NE * 768;
constexpr int XP_SCR_OFF = 65536;
struct XpTile { const float* src; bf16* dst; int ldn, K, k0, c0; size_t r0; };
__device__ __forceinline__ XpTile xp_tile(const Frame& F, int T) {
    XpTile t; const int e = T / 768, r = T % 768;
    if (r < 512) { const int bj = r >> 8, q = r & 255, kt = q >> 4, ct = q & 15; t.c0 = ct * 32; t.k0 = kt * 64;
        t.src = (bj ? F.w_eu : F.w_eg) + (size_t)e * 1024 * 512; t.ldn = 512; t.dst = F.Wgu_t; t.K = 1024; t.r0 = (size_t)e * 1024 + (t.c0 >> 7) * 256 + bj * 128 + (t.c0 & 127); }
    else { const int q = r - 512, kt = q >> 5, ct = q & 31; t.c0 = ct * 32; t.k0 = kt * 64;
        t.src = F.w_ed + (size_t)e * 512 * 1024; t.ldn = 1024; t.dst = F.Wd_t; t.K = 512; t.r0 = (size_t)e * 1024 + t.c0; }
    return t;
}
#define XP_ISSUE(xi_) do { const int NGW_ = F.G * NWAVES; int T_ = F.vcu * NWAVES + F.wave + ((xi_) >> 1) * NGW_; T_ = T_ < XP_TILES ? T_ : XP_TILES - 1; const XpTile t_ = xp_tile(F, T_); \
        const float* p_ = t_.src + (size_t)(t_.k0 + 32 * ((xi_) & 1) + 2 * (F.lane >> 3)) * t_.ldn + t_.c0 + (F.lane & 7) * 4; \
        xa0 = *(const GAS f32x4*)p_; xb0 = *(const GAS f32x4*)(p_ + t_.ldn); xa1 = *(const GAS f32x4*)(p_ + (size_t)16 * t_.ldn); xb1 = *(const GAS f32x4*)(p_ + (size_t)17 * t_.ldn); } while (0)
#define XP_COMMIT(xi_) do { const int NGW_ = F.G * NWAVES; int T_ = F.vcu * NWAVES + F.wave + ((xi_) >> 1) * NGW_; const bool valid_ = T_ < XP_TILES; T_ = valid_ ? T_ : XP_TILES - 1; \
        LAS unsigned* scr_ = (LAS unsigned*)(F.lds + RING_OFF + XP_SCR_OFF + F.wave * 4224); const int n4_ = (F.lane & 7) * 4, kp_ = ((xi_) & 1) * 16 + (F.lane >> 3); \
        scr_[(n4_ + 0) * 33 + kp_] = pk2(xa0.x, xb0.x); scr_[(n4_ + 1) * 33 + kp_] = pk2(xa0.y, xb0.y); scr_[(n4_ + 2) * 33 + kp_] = pk2(xa0.z, xb0.z); scr_[(n4_ + 3) * 33 + kp_] = pk2(xa0.w, xb0.w); \
        scr_[(n4_ + 0) * 33 + kp_ + 8] = pk2(xa1.x, xb1.x); scr_[(n4_ + 1) * 33 + kp_ + 8] = pk2(xa1.y, xb1.y); scr_[(n4_ + 2) * 33 + kp_ + 8] = pk2(xa1.z, xb1.z); scr_[(n4_ + 3) * 33 + kp_ + 8] = pk2(xa1.w, xb1.w); \
        if ((xi_) & 1) { const XpTile t_ = xp_tile(F, T_); LDS_WAIT(); asm volatile("" ::: "memory"); \
            _Pragma("unroll") for (int jj_ = 0; jj_ < 4; ++jj_) { const int n_ = (F.lane >> 3) + 8 * jj_, ch_ = F.lane & 7; v4u o_; \
                o_.x = scr_[n_ * 33 + ch_ * 4 + 0]; o_.y = scr_[n_ * 33 + ch_ * 4 + 1]; o_.z = scr_[n_ * 33 + ch_ * 4 + 2]; o_.w = scr_[n_ * 33 + ch_ * 4 + 3]; \
                if (valid_) *(GAS v4u*)(t_.dst + (t_.r0 + n_) * (size_t)t_.K + t_.k0 + ch_ * 8) = o_; } \
            LDS_WAIT(); asm volatile("" ::: "memory"); } } while (0)

__device__ __forceinline__ int rel_bucket_dev(int d) {
    const int n = d < 0 ? -d : d; int v;
    if (n < 8) v = n; else if (n < 12) v = 8; else if (n < 16) v = 9; else if (n < 23) v = 10; else if (n < 32) v = 11; else if (n < 46) v = 12; else if (n < 64) v = 13; else if (n < 91) v = 14; else v = 15;
    return (d < 0 ? 16 : 0) + v;
}
__device__ __forceinline__ void attn_unit(Frame& F, int b, int h, int qi, float lam, int& xi, int xsteps) {
    LAS unsigned char* lds = F.lds + RING_OFF;
    const int tid = F.tid, lane = F.lane, w = F.wave, mp = w >> 2, rg = w & 3, r32 = lane & 31, hi = lane >> 5;
    const int q0 = qi * 128, qw0 = q0 + rg * 32, qrow = qw0 + r32;
    const size_t rowb = (size_t)b * SEQ;
    const int cw = qw0 >> 6, cmax = (q0 >> 6) + 1;
    LAS bf16x8* qfl = (LAS bf16x8*)(lds + 65536 + 8 * 4224 + w * 4096) + lane;
    {   const bf16* qp = F.Qb + (rowb + qrow) * 512 + h * 128 + mp * 64 + hi * 8;
#pragma unroll
        for (int d0 = 0; d0 < 4; ++d0) qfl[d0 * 64] = *(const GAS bf16x8*)(qp + d0 * 16); }
    const bf16* kg0; const bf16* kg1; const bf16* vg0; const bf16* vg1;
    {   const int key = 8 * w + (lane >> 3), cs = lane & 7, c = cs ^ ((key >> 1) & 7);
        kg0 = F.Kb + (rowb + key) * 512 + h * 128 + c * 8; kg1 = kg0 + 64;
        const int vk = 4 * w + (lane >> 4), vc = (lane & 15) ^ ((vk & 3) << 2);
        vg0 = F.Vb + (rowb + vk) * 512 + h * 128 + vc * 8; vg1 = vg0 + (size_t)32 * 512; }
#define ATT_DMA(j, bf) do { const size_t go_ = (size_t)(j) * 64 * 512; LAS unsigned char* b_ = lds + (bf) * 32768 + w * 1024; \
        __builtin_amdgcn_global_load_lds((const unsigned*)(kg0 + go_), (LAS unsigned*)(b_), 16, 0, 0); __builtin_amdgcn_global_load_lds((const unsigned*)(kg1 + go_), (LAS unsigned*)(b_ + 8192), 16, 0, 0); \
        __builtin_amdgcn_global_load_lds((const unsigned*)(vg0 + go_), (LAS unsigned*)(b_ + 16384), 16, 0, 0); __builtin_amdgcn_global_load_lds((const unsigned*)(vg1 + go_), (LAS unsigned*)(b_ + 16384 + 8192), 16, 0, 0); } while (0)
    ATT_DMA(0, 1); VM_WAIT();
    __syncthreads();
    f32x4 xa0, xb0, xa1, xb1;
    f32x16 o[4];
#pragma unroll
    for (int vb = 0; vb < 4; ++vb)
#pragma unroll
        for (int r = 0; r < 16; ++r) o[vb][r] = 0.f;
    float m_run = -1e30f, l_run = 0.f;
    const LAS float* btab = (const LAS float*)(F.lds + ATT_TAB_OFF) + h * 192;
    const float c15 = btab[191];
    const int kfo = r32 * 128, ksw = (r32 >> 1) & 7;
    const int vsw = (lane & 15) >> 2;
    const int vrow = (4 * hi + vsw) * 256 + 32 * ((lane >> 4) & 1) + 8 * (lane & 3);
    for (int j = 0; j <= cmax; ++j) {
        const int buf = (j + 1) & 1;
        if (j < cmax) ATT_DMA(j + 1, j & 1);
        const bool xact = XP_IN_ATTN && xi < xsteps;
        if (xact) XP_ISSUE(xi);
        if (j <= cw) {
            const LAS unsigned char* kb = lds + buf * 32768 + mp * 8192;
            const LAS unsigned char* vbp = lds + buf * 32768 + 16384;
            const bool far = (64 * j + 154 <= qw0);
            const float ci = far ? c15 : 0.f;
            f32x16 p0, p1;
#pragma unroll
            for (int r = 0; r < 16; ++r) { p0[r] = ci; p1[r] = ci; }
#pragma unroll
            for (int d0 = 0; d0 < 4; ++d0) { const int off = kfo + (((d0 * 2 + hi) ^ ksw) << 4);
                const bf16x8 a0 = *(const LAS bf16x8*)(kb + off), a1 = *(const LAS bf16x8*)(kb + off + 4096);
                const bf16x8 qv = qfl[d0 * 64];
                p0 = __builtin_amdgcn_mfma_f32_32x32x16_bf16(a0, qv, p0, 0, 0, 0);
                p1 = __builtin_amdgcn_mfma_f32_32x32x16_bf16(a1, qv, p1, 0, 0, 0); }
            if (!far) { const int dq = qrow - 64 * j + 63;
#pragma unroll
                for (int r = 0; r < 16; ++r) { const int kk = crow(r, hi); int i0 = dq - kk; i0 = i0 > 191 ? 191 : i0; int i1 = dq - kk - 32; i1 = i1 > 191 ? 191 : i1; p0[r] += btab[i0]; p1[r] += btab[i1]; } }
            float mx = fmaxf(p0[0], p1[0]);
#pragma unroll
            for (int r = 1; r < 16; ++r) mx = fmaxf(mx, fmaxf(p0[r], p1[r]));
            mx = xhalf_max(mx);
            const float m_new = fmaxf(m_run, mx);
            const float alpha = __builtin_amdgcn_exp2f(m_run - m_new);
            float s = 0.f;
#pragma unroll
            for (int r = 0; r < 16; ++r) { p0[r] = __builtin_amdgcn_exp2f(p0[r] - m_new); p1[r] = __builtin_amdgcn_exp2f(p1[r] - m_new); s += p0[r] + p1[r]; }
            l_run = l_run * alpha + s; m_run = m_new;
            if (!__all(alpha == 1.f)) {
#pragma unroll
                for (int vb = 0; vb < 4; ++vb)
#pragma unroll
                    for (int r = 0; r < 16; ++r) o[vb][r] *= alpha; }
            bf16x8 pf[4];
            {   v4u t;
                t.x = pk2(p0[0], p0[1]); t.y = pk2(p0[2], p0[3]); t.z = pk2(p0[4], p0[5]); t.w = pk2(p0[6], p0[7]); pf[0] = __builtin_bit_cast(bf16x8, t);
                t.x = pk2(p0[8], p0[9]); t.y = pk2(p0[10], p0[11]); t.z = pk2(p0[12], p0[13]); t.w = pk2(p0[14], p0[15]); pf[1] = __builtin_bit_cast(bf16x8, t);
                t.x = pk2(p1[0], p1[1]); t.y = pk2(p1[2], p1[3]); t.z = pk2(p1[4], p1[5]); t.w = pk2(p1[6], p1[7]); pf[2] = __builtin_bit_cast(bf16x8, t);
                t.x = pk2(p1[8], p1[9]); t.y = pk2(p1[10], p1[11]); t.z = pk2(p1[12], p1[13]); t.w = pk2(p1[14], p1[15]); pf[3] = __builtin_bit_cast(bf16x8, t); }
#pragma unroll
            for (int vb = 0; vb < 4; ++vb) { const LAS unsigned char* vp = vbp + vrow + ((vb ^ vsw) << 6);
#pragma unroll
                for (int ks = 0; ks < 4; ++ks) {
                    const s16x4 lo = __builtin_bit_cast(s16x4, __builtin_amdgcn_ds_read_tr16_b64_v4i16((LAS s16x4*)(vp + ks * 4096)));
                    const s16x4 hh = __builtin_bit_cast(s16x4, __builtin_amdgcn_ds_read_tr16_b64_v4i16((LAS s16x4*)(vp + ks * 4096 + 2048)));
                    const bf16x8 va = (bf16x8){lo[0], lo[1], lo[2], lo[3], hh[0], hh[1], hh[2], hh[3]};
                    o[vb] = __builtin_amdgcn_mfma_f32_32x32x16_bf16(va, pf[ks], o[vb], 0, 0, 0); } }
        }
        if (xact) { XP_COMMIT(xi); ++xi; }
        VM_WAIT();
        __syncthreads();
    }
#undef ATT_DMA
    const float inv = 1.f / xhalf_sum(l_run);
    LAS unsigned* X = (LAS unsigned*)lds + rg * 2048 + lane;
    if (mp == 1) {
#pragma unroll
        for (int vb = 0; vb < 4; ++vb)
#pragma unroll
            for (int r2 = 0; r2 < 8; ++r2) X[(vb * 8 + r2) * 64] = pk2(o[vb][2 * r2] * inv, o[vb][2 * r2 + 1] * inv); }
    __syncthreads();
    if (mp == 0) {
        float ss = 0.f;
#pragma unroll
        for (int vb = 0; vb < 4; ++vb)
#pragma unroll
            for (int r2 = 0; r2 < 8; ++r2) { const unsigned xw = X[(vb * 8 + r2) * 64];
                const float v0 = o[vb][2 * r2] * inv - lam * bflo(xw), v1 = o[vb][2 * r2 + 1] * inv - lam * bfhi(xw); o[vb][2 * r2] = v0; o[vb][2 * r2 + 1] = v1; ss += v0 * v0 + v1 * v1; }
        ss = xhalf_sum(ss);
        const float rs = rsqrtf(ss * (1.f / 128.f) + EPS) * 0.8f;
        bf16* op = F.AO + (rowb + qrow) * 512 + h * 128;
#pragma unroll
        for (int vb = 0; vb < 4; ++vb)
#pragma unroll
            for (int rq = 0; rq < 4; ++rq) { const int v0 = vb * 32 + 8 * rq + 4 * hi; const f32x4 g = *(const GAS f32x4*)(F.gsub + v0); v2u ow;
                ow.x = pk2(o[vb][4 * rq + 0] * rs * g.x, o[vb][4 * rq + 1] * rs * g.y); ow.y = pk2(o[vb][4 * rq + 2] * rs * g.z, o[vb][4 * rq + 3] * rs * g.w);
                *(GAS v2u*)(op + v0) = ow; }
    }
}
__device__ __forceinline__ void p2_mixers(Frame& F) {
#ifdef DBG_NO_CONV
    for (size_t i = (size_t)blockIdx.x * 512 + F.tid; i < (size_t)M * 512 * 2 / 16; i += (size_t)F.G * 512) ((GAS v4u*)F.UC)[i] = (v4u){0u, 0u, 0u, 0u};
#else
#ifdef REP_CONV
    for (int rep = 0; rep < 2; ++rep)
#endif
    for (int u = F.vcu; u < M / 32; u += F.G) conv_unit(F, u);
#endif
    {   LAS float* bt = (LAS float*)(F.lds + ATT_TAB_OFF);
        for (int i = F.tid; i < NH * 192; i += 512) { const int h = i / 192, d = i % 192 - 63; bt[i] = F.relb[rel_bucket_dev(d) * NH + h] * LOG2E; } }
    int xi = 0; const int xsteps = 2 * ((XP_TILES + F.G * NWAVES - 1) / (F.G * NWAVES));
    float lam;
    {   const float a = wave_sum(F.lq1[F.lane] * F.lk1[F.lane]), c = wave_sum(F.lq2[F.lane] * F.lk2[F.lane]); lam = __expf(a) - __expf(c) + 0.2f; }
    __syncthreads();
#ifdef DBG_NO_ATT
    for (size_t i = (size_t)blockIdx.x * 512 + F.tid; i < (size_t)M * 512 * 2 / 16; i += (size_t)F.G * 512) ((GAS v4u*)F.AO)[i] = (v4u){0u, 0u, 0u, 0u};
    if (lam == 123.f) F.AO[0] = 1;
#else
#ifdef REP_ATT
    for (int rep = 0; rep < 2; ++rep)
#endif
    for (int v = F.vcu; v < 256; v += F.G) { const int bh = v >> 4, s = v & 15;
#pragma unroll 1
        for (int k = 0; k < 2; ++k) attn_unit(F, bh >> 2, bh & 3, k ? 31 - s : s, lam, xi, xsteps); }
#endif
    __syncthreads();
    if (XP_IN_ATTN) { f32x4 xa0, xb0, xa1, xb1; while (xi < xsteps) { XP_ISSUE(xi); XP_COMMIT(xi); ++xi; } }
    __syncthreads();
}

typedef float f32x4v __attribute__((ext_vector_type(4)));
__device__ __forceinline__ void p5a_router(Frame& F, bool dry) {
    LAS unsigned char* lds = F.lds + RING_OFF;
    LAS float* LP = (LAS float*)lds;
    LAS float* SS = (LAS float*)(lds + 40960);
    LAS int* lcnt = (LAS int*)(lds + 40960 + 512);
    LAS int* lbase = (LAS int*)(lds + 40960 + 768);
    const int tid = F.tid, lane = F.lane, w = F.wave, rt = w & 3, kh = w >> 2, r16 = lane & 15, kq = lane >> 4;
    for (int blk = F.vcu; blk < M / 64; blk += F.G) {
        if (tid < 64) lcnt[tid] = 0;
        {   const int row = blk * 64 + rt * 16 + r16;
            const float* xp = F.out + (size_t)row * D + kh * 512 + 4 * kq;
            const GAS f32x4* wf = (const GAS f32x4*)F.Wrf + (size_t)(kh * 32) * 5 * 64 + lane;
            f32x4 acc[5]; float ss = 0.f;
#pragma unroll
            for (int ct = 0; ct < 5; ++ct) acc[ct] = (f32x4){0.f, 0.f, 0.f, 0.f};
#pragma unroll 4
            for (int kc = 0; kc < 32; ++kc) {
                const f32x4 a = *(const GAS f32x4*)(xp + kc * 16);
                f32x4 bw[5];
#pragma unroll
                for (int ct = 0; ct < 5; ++ct) bw[ct] = wf[(kc * 5 + ct) * 64];
                ss += (a.x * a.x + a.y * a.y) + (a.z * a.z + a.w * a.w);
#pragma unroll
                for (int ct = 0; ct < 5; ++ct) {
                    acc[ct] = __builtin_amdgcn_mfma_f32_16x16x4f32(a.x, bw[ct].x, acc[ct], 0, 0, 0);
                    acc[ct] = __builtin_amdgcn_mfma_f32_16x16x4f32(a.y, bw[ct].y, acc[ct], 0, 0, 0);
                    acc[ct] = __builtin_amdgcn_mfma_f32_16x16x4f32(a.z, bw[ct].z, acc[ct], 0, 0, 0);
                    acc[ct] = __builtin_amdgcn_mfma_f32_16x16x4f32(a.w, bw[ct].w, acc[ct], 0, 0, 0); }
            }
            ss += __shfl_xor(ss, 16); ss += __shfl_xor(ss, 32);
            if (kq == 0) SS[kh * 64 + rt * 16 + r16] = ss;
#pragma unroll
            for (int ct = 0; ct < 5; ++ct)
#pragma unroll
                for (int rg = 0; rg < 4; ++rg) LP[(kh * 64 + rt * 16 + 4 * kq + rg) * 80 + ct * 16 + r16] = acc[ct][rg];
        }
        __syncthreads();
        int e0 = 0, e1 = 0, rk0 = 0, rk1 = 0; float w0 = 0.f, w1 = 0.f, rstd = 0.f;
        if (tid < 64) {
            const int r = tid; const LAS float* l0 = LP + r * 80; const LAS float* l1 = LP + (64 + r) * 80;
            rstd = rsqrtf((SS[r] + SS[64 + r]) * (1.f / D) + EPS);
            float lg[8]; int grp = 0; float mx = -3.0e38f;
#pragma unroll
            for (int g = 0; g < 8; ++g) { lg[g] = (l0[g] + l1[g]) * rstd + F.b_rg[g]; if (lg[g] > mx) { mx = lg[g]; grp = g; } }
            float den = 0.f;
#pragma unroll
            for (int g = 0; g < 8; ++g) den += __expf(lg[g] - mx);
            const float pg = 1.f / den;
            float v0 = -3.0e38f, v1 = -3.0e38f; int j0 = 0, j1 = 0;
            for (int j = 0; j < 8; ++j) { const float le = (l0[8 + grp * 8 + j] + l1[8 + grp * 8 + j]) * rstd + F.b_re[grp * 8 + j];
                if (le > v0) { v1 = v0; j1 = j0; v0 = le; j0 = j; } else if (le > v1) { v1 = le; j1 = j; } }
            w0 = pg / (1.f + __expf(v1 - v0)); w1 = pg - w0;
            e0 = grp * 8 + j0; e1 = grp * 8 + j1;
            rk0 = __hip_atomic_fetch_add(lcnt + e0, 1, __ATOMIC_RELAXED, __HIP_MEMORY_SCOPE_WORKGROUP);
            rk1 = __hip_atomic_fetch_add(lcnt + e1, 1, __ATOMIC_RELAXED, __HIP_MEMORY_SCOPE_WORKGROUP);
        }
        __syncthreads();
        if (tid < 64) { const int c = lcnt[tid]; lbase[tid] = (c > 0 && !dry) ? (int)__hip_atomic_fetch_add(F.ctl + CW_GCNT + 64 * tid, (unsigned)c, RLX_AGENT) : 0; }
        __syncthreads();
        if (tid < 64) { int* ti = F.tokinfo + (size_t)(blk * 64 + tid) * 8;
            ti[0] = e0; ti[1] = e1; ti[2] = lbase[e0] + rk0; ti[3] = lbase[e1] + rk1; ti[4] = __float_as_int(w0); ti[5] = __float_as_int(w1); ti[6] = __float_as_int(rstd); ti[7] = 0; }
        __syncthreads();
    }
}
__device__ __forceinline__ void p5b_gather(Frame& F) {
    moe_tables(F);
    const LAS int* tab = (const LAS int*)(F.lds + MOE_TAB_OFF);
    LAS int* rowinfo = (LAS int*)(F.lds + RING_OFF);
    const int tid = F.tid, lane = F.lane, w = F.wave;
    for (int blk = F.vcu; blk < M / 64; blk += F.G) {
        if (tid < 64) { const int t = blk * 64 + tid; const int* ti = F.tokinfo + (size_t)t * 8;
            const int e0 = ti[0], e1 = ti[1]; const int s0 = tab[64 + e0] * 256 + ti[2], s1 = tab[64 + e1] * 256 + ti[3];
            F.tokslot[2 * t] = s0; F.tokslot[2 * t + 1] = s1; F.roww[s0] = __int_as_float(ti[4]); F.roww[s1] = __int_as_float(ti[5]);
            rowinfo[tid * 4 + 0] = s0; rowinfo[tid * 4 + 1] = s1; rowinfo[tid * 4 + 2] = ti[6]; }
        __syncthreads();
        for (int k = 0; k < 8; k += 2) {
            f32x4 xa[2][2][2]; int sl[2][2]; float rsd[2];
#pragma unroll
            for (int q = 0; q < 2; ++q) { const int r = w * 8 + k + q, t = blk * 64 + r; sl[q][0] = rowinfo[r * 4]; sl[q][1] = rowinfo[r * 4 + 1]; rsd[q] = __int_as_float(rowinfo[r * 4 + 2]);
                const float* xr = F.out + (size_t)t * D;
#pragma unroll
                for (int hf = 0; hf < 2; ++hf) { const int c = hf * 512 + lane * 8; xa[q][hf][0] = *(const GAS f32x4*)(xr + c); xa[q][hf][1] = *(const GAS f32x4*)(xr + c + 4); } }
#pragma unroll
            for (int hf = 0; hf < 2; ++hf) { const int c = hf * 512 + lane * 8; const f32x4 ga = *(const GAS f32x4*)(F.g_ffn + c), gb = *(const GAS f32x4*)(F.g_ffn + c + 4);
#pragma unroll
                for (int q = 0; q < 2; ++q) { const f32x4 a = xa[q][hf][0] * rsd[q] * ga, b = xa[q][hf][1] * rsd[q] * gb; v4u o;
                    o.x = pk2(a.x, a.y); o.y = pk2(a.z, a.w); o.z = pk2(b.x, b.y); o.w = pk2(b.z, b.w);
                    *(GAS v4u*)(F.XG + (size_t)sl[q][0] * D + c) = o; *(GAS v4u*)(F.XG + (size_t)sl[q][1] * D + c) = o; } } }
        __syncthreads();
    }
}
__device__ __forceinline__ void p8_final(Frame& F, float* dstbase) {
    const int gw = F.vcu * NWAVES + F.wave, NGW = F.G * NWAVES, lane = F.lane;
    const GAS f32x4* gr = (const GAS f32x4*)F.g_fin + lane;
    for (int m0 = gw; m0 < M; m0 += 2 * NGW) {
        const int m1 = m0 + NGW < M ? m0 + NGW : m0;
        const int sa0 = F.tokslot[2 * m0], sa1 = F.tokslot[2 * m0 + 1], sb0 = F.tokslot[2 * m1], sb1 = F.tokslot[2 * m1 + 1];
        const GAS f32x4* xa = (const GAS f32x4*)(F.out + (size_t)m0 * D) + lane; const GAS f32x4* xb = (const GAS f32x4*)(F.out + (size_t)m1 * D) + lane;
        const GAS v2u* ya0 = (const GAS v2u*)(F.Y + (size_t)sa0 * D) + lane; const GAS v2u* ya1 = (const GAS v2u*)(F.Y + (size_t)sa1 * D) + lane;
        const GAS v2u* yb0 = (const GAS v2u*)(F.Y + (size_t)sb0 * D) + lane; const GAS v2u* yb1 = (const GAS v2u*)(F.Y + (size_t)sb1 * D) + lane;
        f32x4 va[4], vb[4]; v2u pa[4], qa[4], pb[4], qb[4];
#pragma unroll
        for (int j = 0; j < 4; ++j) { va[j] = xa[64 * j]; pa[j] = ya0[64 * j]; qa[j] = ya1[64 * j]; vb[j] = xb[64 * j]; pb[j] = yb0[64 * j]; qb[j] = yb1[64 * j]; }
        float s0 = 0.f, s1 = 0.f;
#pragma unroll
        for (int j = 0; j < 4; ++j) {
            va[j].x += bflo(pa[j].x) + bflo(qa[j].x); va[j].y += bfhi(pa[j].x) + bfhi(qa[j].x); va[j].z += bflo(pa[j].y) + bflo(qa[j].y); va[j].w += bfhi(pa[j].y) + bfhi(qa[j].y);
            vb[j].x += bflo(pb[j].x) + bflo(qb[j].x); vb[j].y += bfhi(pb[j].x) + bfhi(qb[j].x); vb[j].z += bflo(pb[j].y) + bflo(qb[j].y); vb[j].w += bfhi(pb[j].y) + bfhi(qb[j].y);
            s0 += (va[j].x * va[j].x + va[j].y * va[j].y) + (va[j].z * va[j].z + va[j].w * va[j].w);
            s1 += (vb[j].x * vb[j].x + vb[j].y * vb[j].y) + (vb[j].z * vb[j].z + vb[j].w * vb[j].w); }
        const float r0 = rsqrtf(wave_sum(s0) * (1.f / D) + EPS), r1 = rsqrtf(wave_sum(s1) * (1.f / D) + EPS);
        GAS f32x4* oa = (GAS f32x4*)(dstbase + (size_t)m0 * D) + lane; GAS f32x4* ob = (GAS f32x4*)(dstbase + (size_t)m1 * D) + lane;
#pragma unroll
        for (int j = 0; j < 4; ++j) { const f32x4 g = gr[64 * j];
            oa[64 * j] = (f32x4){va[j].x * r0 * g.x, va[j].y * r0 * g.y, va[j].z * r0 * g.z, va[j].w * r0 * g.w};
            if (m1 != m0) ob[64 * j] = (f32x4){vb[j].x * r1 * g.x, vb[j].y * r1 * g.y, vb[j].z * r1 * g.z, vb[j].w * r1 * g.w}; }
    }
}

struct Args { const float* in[26]; float* out; unsigned char* ws; int ph_lo, ph_hi; };
__global__ void __launch_bounds__(NWAVES * 64, 2) fwd_kernel(Args args) {
    extern __shared__ __attribute__((aligned(16))) unsigned char lds[];
    Frame F;
    F.lds = (LAS unsigned char*)lds;
    F.tid = threadIdx.x; F.lane = F.tid & 63; F.wave = __builtin_amdgcn_readfirstlane(F.tid >> 6);
    F.G = gridDim.x; { const int bx = blockIdx.x; F.vcu = (F.G % 8 == 0) ? (bx % 8) * (F.G / 8) + bx / 8 : bx; }
    unsigned char* ws = args.ws;
    F.ctl = (gu32*)(ws + WS_CTL);
    F.x = args.in[0]; F.w_in = args.in[1]; F.lq1 = args.in[2]; F.lk1 = args.in[3]; F.lq2 = args.in[4]; F.lk2 = args.in[5]; F.gsub = args.in[6]; F.relb = args.in[7];
    F.w_au = args.in[8]; F.w_dw = args.in[9]; F.b_dw = args.in[10]; F.g_cln = args.in[11]; F.b_cln = args.in[12]; F.w_pw = args.in[13]; F.b_pw = args.in[14]; F.w_out = args.in[15];
    F.g_mix = args.in[16]; F.g_ffn = args.in[17]; F.w_rg = args.in[18]; F.b_rg = args.in[19]; F.w_re = args.in[20]; F.b_re = args.in[21]; F.w_eg = args.in[22]; F.w_eu = args.in[23]; F.w_ed = args.in[24]; F.g_fin = args.in[25];
    F.out = args.out;
    F.Win_t = (bf16*)(ws + WS_WIN); F.Wmix_t = (bf16*)(ws + WS_WMIX); F.Wout_t = (bf16*)(ws + WS_WOUT); F.Wgu_t = (bf16*)(ws + WS_WGU); F.Wd_t = (bf16*)(ws + WS_WD);
    F.XN = (bf16*)(ws + WS_XN); F.Qb = (bf16*)(ws + WS_Q); F.Kb = (bf16*)(ws + WS_K); F.Vb = (bf16*)(ws + WS_V); F.U = (bf16*)(ws + WS_U); F.Gt = (bf16*)(ws + WS_G);
    F.AO = (bf16*)(ws + WS_AO); F.UC = (bf16*)(ws + WS_UC); F.MG = (bf16*)(ws + WS_MG); F.XG = (bf16*)(ws + WS_XG); F.ACT = (bf16*)(ws + WS_ACT); F.Y = (bf16*)(ws + WS_Y);
    F.T = (float*)(ws + WS_T); F.Wrf = (float*)(ws + WS_WRF); F.roww = (float*)(ws + WS_ROWW); F.tokinfo = (int*)(ws + WS_TOKINFO); F.tokslot = (int*)(ws + WS_TOKSLOT);
    for (int u = F.tid; u < 128; u += NWAVES * 64) ((LAS unsigned*)(F.lds + LDSCTL_OFF))[u] = 0u;
    __syncthreads();
    const int lo = args.ph_lo, hi = args.ph_hi;
    XcdBarrier bar; bar.bar = (unsigned*)(F.ctl + CW_BAR); bar.x = 0; bar.st = nullptr;
    if (hi - lo > 1) bar = xcd_barrier_post((unsigned*)(F.ctl + CW_BAR), (volatile LAS unsigned*)(F.lds + LDSCTL_OFF) + 8);
#ifndef PH_MASK
#define PH_MASK 0x3ff
#endif
#define IN(k) (((PH_MASK >> (k)) & 1) && lo <= (k) && (k) < hi)
#ifdef REP_BAR
#define SEAM(k) do { if (IN(k) && IN((k) + 1)) { xcd_barrier(bar); xcd_barrier(bar); } } while (0)
#else
#define SEAM(k) do { if (IN(k) && IN((k) + 1)) xcd_barrier(bar); } while (0)
#endif
    constexpr bool AL = true, SP = true;
#ifndef REP_MASK
#define REP_MASK 0
#endif
#define REPS(k) ((((REP_MASK) >> (k)) & 1) ? 2 : 1)

    if (IN(0)) { for (int rep = 0; rep < REPS(0); ++rep) { p0_prologue(F); if (rep + 1 < REPS(0)) __syncthreads(); } SEAM(0); }
    if (IN(1)) { for (int rep = 0; rep < REPS(1); ++rep) {
        pg8::Gemm g{F.XN, F.Win_t, M, NCOL, D}; pg8::StaticOrder S; S.init(M, NCOL, F.G, (int)blockIdx.x);
        EpiProj E{F.Qb, F.Kb, F.Vb, F.U, F.Gt};
        pg8::gemm_phase<EpiProj, pg8::StaticOrder, AL, SP>(F.lds + RING_OFF, g, S, E); }
        SEAM(1);
    }
#if defined(DBG_ZERO_P2)
    if (IN(2)) { for (size_t i = (size_t)blockIdx.x * 512 + F.tid; i < (size_t)M * 1024 * 2 / 16; i += (size_t)F.G * 512) ((GAS v4u*)F.AO)[i] = ((const GAS v4u*)F.XN)[i]; SEAM(2); }
#else
    if (IN(2)) { for (int rep = 0; rep < REPS(2); ++rep) p2_mixers(F); SEAM(2); }
#endif
    if (IN(3)) { for (int rep = 0; rep < REPS(3); ++rep) {
        pg8::Gemm g{F.AO, F.Wmix_t, 2 * M, 2048, 512}; PairOrder S; S.so.init(M, 1024, F.G, (int)blockIdx.x);
        EpiMerge E{F.Gt, F.b_pw, F.T + (size_t)blockIdx.x * 65536, F.MG};
        pg8::gemm_phase<EpiMerge, PairOrder, AL, SP>(F.lds + RING_OFF, g, S, E); }
        SEAM(3);
    }
    if (IN(4)) { for (int rep = 0; rep < REPS(4); ++rep) {
        pg8::Gemm g{F.MG, F.Wout_t, M, D, D}; pg8::StaticOrder S; S.init(M, D, F.G, (int)blockIdx.x);
        EpiX1 E{F.x, F.out};
        pg8::gemm_phase<EpiX1, pg8::StaticOrder, AL, SP>(F.lds + RING_OFF, g, S, E); }
        SEAM(4);
    }
#ifdef REP_P5A
    if (IN(5)) { p5a_router(F, true); __syncthreads(); }
#endif
    if (IN(5)) { p5a_router(F, false); SEAM(5); }
    if (IN(6)) { for (int rep = 0; rep < REPS(6); ++rep) p5b_gather(F); SEAM(6); }
    if (IN(7)) { for (int rep = 0; rep < REPS(7); ++rep) {
        moe_tables(F);
        const LAS int* tab = (const LAS int*)(F.lds + MOE_TAB_OFF);
        pg8::Gemm g{F.XG, F.Wgu_t, MAXTILES * 256, NE * 1024, D}; MoeOrder S{tab + 129, tab[129 + MAXTILES], F.G, F.vcu};
        EpiSwiglu E{F.ACT};
        pg8::gemm_phase<EpiSwiglu, MoeOrder, AL, SP>(F.lds + RING_OFF, g, S, E); }
        SEAM(7);
    }
    if (IN(8)) { for (int rep = 0; rep < REPS(8); ++rep) {
        moe_tables(F);
        const LAS int* tab = (const LAS int*)(F.lds + MOE_TAB_OFF);
        pg8::Gemm g{F.ACT, F.Wd_t, MAXTILES * 256, NE * 1024, DE}; MoeOrder S{tab + 129, tab[129 + MAXTILES], F.G, F.vcu};
        EpiDown E{F.Y, F.roww};
        pg8::gemm_phase<EpiDown, MoeOrder, AL, SP>(F.lds + RING_OFF, g, S, E); }
        SEAM(8);
    }
#ifdef REP_P9
    if (IN(9)) { p8_final(F, (float*)F.XG); __syncthreads(); }
#endif
    if (IN(9)) { p8_final(F, F.out); }
#undef IN
#undef SEAM
}

#ifndef MK_N_LAUNCHES
#define MK_N_LAUNCHES 1
#endif
extern "C" void kernel_launch(void* const* d_in, const int* in_sizes, int n_in, void* d_out, int out_size, void* d_ws, size_t ws_size, hipStream_t stream) {
    static int grid = 0;
    if (grid == 0) {
        if (n_in != 26 || in_sizes[0] != M * D || out_size != M * D || ws_size < WS_END) { fprintf(stderr, "kernel_launch: unexpected shapes (n_in %d, in0 %d, out %d, ws %zu < %zu)\n", n_in, n_in > 0 ? in_sizes[0] : -1, out_size, ws_size, (size_t)WS_END); grid = -1; return; }
        int dev = 0, cus = 0, per_cu = 0;
        if (hipGetDevice(&dev) != hipSuccess || hipDeviceGetAttribute(&cus, hipDeviceAttributeMultiprocessorCount, dev) != hipSuccess) { grid = -1; return; }
        if (hipFuncSetAttribute((const void*)fwd_kernel, hipFuncAttributeMaxDynamicSharedMemorySize, LDS_BYTES) != hipSuccess) { fprintf(stderr, "kernel_launch: hipFuncSetAttribute failed\n"); grid = -1; return; }
        if (hipOccupancyMaxActiveBlocksPerMultiprocessor(&per_cu, (const void*)fwd_kernel, NWAVES * 64, LDS_BYTES) != hipSuccess || per_cu < 1)
            fprintf(stderr, "kernel_launch: occupancy query reports %d workgroups per CU\n", per_cu);
        (void)hipGetLastError();
        grid = cus;
    }
    if (grid < 0) return;
    if (hipMemsetAsync((char*)d_ws + WS_CTL, 0, CTL_ZERO_BYTES, stream) != hipSuccess) return;
    Args a{};
    for (int i = 0; i < 26; ++i) a.in[i] = (const float*)d_in[i];
    a.out = (float*)d_out; a.ws = (unsigned char*)d_ws;
#if MK_N_LAUNCHES == 1
    a.ph_lo = 0; a.ph_hi = NPHASE;
    hipLaunchKernelGGL(fwd_kernel, dim3(grid), dim3(NWAVES * 64), LDS_BYTES, stream, a);
#else
    for (int p = 0; p < NPHASE; ++p) { a.ph_lo = p; a.ph_hi = p + 1; hipLaunchKernelGGL(fwd_kernel, dim3(grid), dim3(NWAVES * 64), LDS_BYTES, stream, a); }
#endif
}
```

```cpp
#include <hip/hip_runtime.h>
#include <cstdio>
#include <cstdint>
#define MK_N_LAUNCHES 1
#define REP_MASK 0
namespace pg8 {
#define PG8_LAS __attribute__((address_space(3)))
typedef unsigned short bf16_t;
typedef short bf16x8 __attribute__((ext_vector_type(8)));
typedef float f32x4 __attribute__((ext_vector_type(4)));
typedef unsigned u32x4 __attribute__((ext_vector_type(4)));
constexpr int BM = 256, BK = 64, HALF = 128, HTB = HALF * BK * 2  , STAGE_BYTES = 8 * HTB, NXCD = 8, WGM = 8;

__host__ __device__ __forceinline__ int lds_byte(int r, int c) { const int st = (r >> 4) * 2 + (c >> 5), rr = r & 15, cc = c & 31, ob = rr * 64 + cc * 2; return st * 1024 + (ob ^ (((ob >> 9) & 1) << 5)); }
__host__ __device__ __forceinline__ void stage_rc(int b, int& R, int& C) { const int st = b / 1024, sb = b % 1024, swz = sb ^ (((sb >> 9) & 1) << 5); R = (st >> 1) * 16 + swz / 64; C = (st & 1) * 32 + (swz % 64) / 2; }
__host__ __device__ __forceinline__ int perm32(int rho) { const int n = rho >> 4, i = rho & 15; return 8 * (i >> 2) + 4 * n + (i & 3); }

struct Unit { int pm, pn; };
struct Gemm { const bf16_t* A; const bf16_t* Bt; int M, N, K; };

struct StaticOrder {
    int nM, nN, nwg, G, c;
    __host__ __device__ void init(int M, int N, int G_, int c_) { nM = M / BM; nN = N / BM; nwg = nM * nN; G = G_; c = c_; }
    __host__ __device__ bool next(int i, Unit& u) const {
        const long L = (long)i * G + c; if (L >= nwg) return false;
        int wgid = (int)L; { const int q = nwg / NXCD, r = nwg % NXCD, xcd = wgid % NXCD, off = wgid / NXCD; wgid = (xcd < r ? xcd * (q + 1) : r * (q + 1) + (xcd - r) * q) + off; }
        const int nig = WGM * nN, gid = wgid / nig, fm = gid * WGM, gsz = (nM - fm) < WGM ? (nM - fm) : WGM;
        u.pm = fm + ((wgid % nig) % gsz); u.pn = (wgid % nig) / gsz; return true;
    }
    __device__ __forceinline__ void a_ready(const Unit&) const {}
    __device__ __forceinline__ void done(const Unit&) const {}
};

__device__ __forceinline__ unsigned cvt_pk_bf16(float lo, float hi) { unsigned r; asm volatile("v_cvt_pk_bf16_f32 %0, %1, %2" : "=v"(r) : "v"(lo), "v"(hi)); return r; }
typedef float f32x2 __attribute__((ext_vector_type(2)));
template <class Epi, class Sched, bool ALIGN_EPI = false, bool SP2 = false>
__device__ __forceinline__ void gemm_phase(PG8_LAS unsigned char* lds, const Gemm g, const Sched& S, const Epi& E) {
    const int tid = threadIdx.x, wid = __builtin_amdgcn_readfirstlane(tid >> 6), lane = tid & 63, wr = wid >> 2, wc = wid & 3, fr = lane & 15, fq = lane >> 4;
    const int K = g.K, nt = K / BK;
    unsigned voffA[2], voffB[2];
#pragma unroll
    for (int i = 0; i < 2; ++i) { int R, C; stage_rc(tid * 16 + i * 8192, R, C); const int Rb = Epi::PERM ? ((R & ~31) + perm32(R & 31)) : R;
        voffA[i] = (unsigned)(R * K + C) * 2u; voffB[i] = (unsigned)(Rb * K + C) * 2u; }
    const size_t kstep = (size_t)(BK * 2);
    const size_t hstep = (size_t)HALF * K * 2;
    const size_t tstep = 2 * hstep;
    const unsigned ldsw = (unsigned)wid * 1024u;
    const int aoff = lds_byte(wr * 64 + fr, fq * 8), boff = lds_byte(wc * 32 + fr, fq * 8);
#define PG8_SA(b, h) (((b) * 2 + (h)) * HTB)
#define PG8_SB(b, h) ((4 + (b) * 2 + (h)) * HTB)
#define PG8_STAGE(bufoff, gbase, voff) do { _Pragma("unroll") for (int _i = 0; _i < 2; ++_i) \
        __builtin_amdgcn_global_load_lds((const unsigned*)((const char*)(gbase) + (voff)[_i]), (PG8_LAS unsigned*)(lds + (bufoff) + ldsw + _i * 8192), 16, 0, 0); } while (0)
#define PG8_LDA(dst, b, h) do { _Pragma("unroll") for (int m = 0; m < 4; ++m) _Pragma("unroll") for (int k = 0; k < 2; ++k) dst[m][k] = *(const PG8_LAS bf16x8*)(lds + PG8_SA(b, h) + aoff + m * 2048 + k * 1024); } while (0)
#define PG8_LDB(dst, b, h) do { _Pragma("unroll") for (int n = 0; n < 2; ++n) _Pragma("unroll") for (int k = 0; k < 2; ++k) dst[n][k] = *(const PG8_LAS bf16x8*)(lds + PG8_SB(b, h) + boff + n * 2048 + k * 1024); } while (0)
#define PG8_MMA(ai, bj, At, Bt) do { __builtin_amdgcn_s_setprio(1); _Pragma("unroll") for (int m = 0; m < 4; ++m) _Pragma("unroll") for (int n = 0; n < 2; ++n) _Pragma("unroll") for (int k = 0; k < 2; ++k) \
        acc[ai][bj][m][n] = __builtin_amdgcn_mfma_f32_16x16x32_bf16(Bt[n][k], At[m][k], acc[ai][bj][m][n], 0, 0, 0); __builtin_amdgcn_s_setprio(0); } while (0)
#define PG8_WAIT_V(n) asm volatile("s_waitcnt vmcnt(" #n ")" ::: "memory")
#define PG8_WAIT_L(n) asm volatile("s_waitcnt lgkmcnt(" #n ")" ::: "memory")
#define PG8_BAR __builtin_amdgcn_s_barrier()
#define PG8_SCHED __builtin_amdgcn_sched_barrier(0)
    Unit cur, nxt; int ui = 0;
    if (!S.next(0, cur)) return;
    f32x4 acc[2][2][4][2];
#pragma unroll
    for (int a = 0; a < 2; ++a)
#pragma unroll
        for (int b = 0; b < 2; ++b)
#pragma unroll
            for (int m = 0; m < 4; ++m)
#pragma unroll
                for (int n = 0; n < 2; ++n) acc[a][b][m][n] = (f32x4){0.f, 0.f, 0.f, 0.f};
    bf16x8 At[4][2], B0[2][2], B1[2][2];
    const char* cA = (const char*)g.A + (size_t)cur.pm * tstep; const char* cB = (const char*)g.Bt + (size_t)cur.pn * tstep;
    S.a_ready(cur);
    if constexpr (SP2) {
        PG8_STAGE(PG8_SB(0, 0), cB, voffB); PG8_STAGE(PG8_SB(0, 1), cB + hstep, voffB); PG8_STAGE(PG8_SA(0, 0), cA, voffA); PG8_STAGE(PG8_SA(0, 1), cA + hstep, voffA);
        if (wr == 1) PG8_BAR;
        PG8_WAIT_V(2); PG8_BAR;
        PG8_STAGE(PG8_SB(1, 0), cB + kstep, voffB); PG8_STAGE(PG8_SA(1, 0), cA + kstep, voffA); PG8_STAGE(PG8_SB(1, 1), cB + hstep + kstep, voffB);
        PG8_WAIT_V(6); PG8_BAR;
    } else {
        PG8_STAGE(PG8_SB(0, 0), cB, voffB); PG8_STAGE(PG8_SA(0, 0), cA, voffA); PG8_STAGE(PG8_SB(0, 1), cB + hstep, voffB); PG8_STAGE(PG8_SA(0, 1), cA + hstep, voffA);
        if (wr == 1) PG8_BAR;
        PG8_WAIT_V(4); PG8_BAR;
        PG8_STAGE(PG8_SB(1, 0), cB + kstep, voffB); PG8_STAGE(PG8_SA(1, 0), cA + kstep, voffA); PG8_STAGE(PG8_SB(1, 1), cB + hstep + kstep, voffB);
        PG8_WAIT_V(6); PG8_BAR;
    }
    for (;;) {
        const bool has_next = S.next(ui + 1, nxt);
        const char* nA = has_next ? (const char*)g.A + (size_t)nxt.pm * tstep : cA; const char* nB = has_next ? (const char*)g.Bt + (size_t)nxt.pn * tstep : cB;
        for (int t = 0; t < nt; t += 2) {
            const bool last = (t == nt - 2);
            const char* a1 = cA + (size_t)(t + 1) * kstep;
            const char* a2 = last ? nA : cA + (size_t)(t + 2) * kstep; const char* b2 = last ? nB : cB + (size_t)(t + 2) * kstep;
            const char* a3 = a2 + kstep; const char* b3 = b2 + kstep;
            if (last && has_next) S.a_ready(nxt);
            if constexpr (SP2) {
            PG8_LDB(B0, 0, 0); PG8_LDB(B1, 0, 1); PG8_SCHED; PG8_LDA(At, 0, 0); PG8_STAGE(PG8_SA(1, 1), a1 + hstep, voffA);
            PG8_WAIT_V(8); PG8_WAIT_L(0); PG8_BAR; PG8_MMA(0, 0, At, B0); PG8_MMA(0, 1, At, B1); PG8_BAR; PG8_SCHED;
            PG8_LDA(At, 0, 1); PG8_STAGE(PG8_SB(0, 0), b2, voffB); PG8_STAGE(PG8_SB(0, 1), b2 + hstep, voffB); PG8_STAGE(PG8_SA(0, 0), a2, voffA);
            PG8_WAIT_V(8); PG8_WAIT_L(0); PG8_BAR; PG8_MMA(1, 0, At, B0); PG8_MMA(1, 1, At, B1); PG8_BAR; PG8_SCHED;
            PG8_LDB(B0, 1, 0); PG8_LDB(B1, 1, 1); PG8_SCHED; PG8_LDA(At, 1, 0); PG8_STAGE(PG8_SA(0, 1), a2 + hstep, voffA);
            PG8_WAIT_V(8); PG8_WAIT_L(0); PG8_BAR; PG8_MMA(0, 0, At, B0); PG8_MMA(0, 1, At, B1); PG8_BAR; PG8_SCHED;
            PG8_LDA(At, 1, 1); PG8_STAGE(PG8_SB(1, 0), b3, voffB); PG8_STAGE(PG8_SB(1, 1), b3 + hstep, voffB); PG8_STAGE(PG8_SA(1, 0), a3, voffA);
            PG8_WAIT_V(8); PG8_WAIT_L(0); PG8_BAR; PG8_MMA(1, 0, At, B0); PG8_MMA(1, 1, At, B1); PG8_BAR; PG8_SCHED;
            } else {
            PG8_LDB(B0, 0, 0); PG8_SCHED; PG8_LDA(At, 0, 0); PG8_STAGE(PG8_SA(1, 1), a1 + hstep, voffA);
            PG8_WAIT_L(8); PG8_BAR; PG8_WAIT_L(0); PG8_MMA(0, 0, At, B0); PG8_BAR; PG8_SCHED;
            PG8_LDB(B1, 0, 1); PG8_STAGE(PG8_SB(0, 0), b2, voffB);
            PG8_BAR; PG8_WAIT_L(0); PG8_MMA(0, 1, At, B1); PG8_BAR;
            PG8_LDA(At, 0, 1); PG8_STAGE(PG8_SA(0, 0), a2, voffA);
            PG8_BAR; PG8_WAIT_L(0); PG8_MMA(1, 0, At, B0); PG8_BAR; PG8_SCHED;
            PG8_STAGE(PG8_SB(0, 1), b2 + hstep, voffB);
            PG8_WAIT_V(6); PG8_BAR; PG8_MMA(1, 1, At, B1); PG8_BAR;
            PG8_LDB(B0, 1, 0); PG8_SCHED; PG8_LDA(At, 1, 0); PG8_STAGE(PG8_SA(0, 1), a2 + hstep, voffA);
            PG8_WAIT_L(8); PG8_BAR; PG8_WAIT_L(0); PG8_MMA(0, 0, At, B0); PG8_BAR; PG8_SCHED;
            PG8_LDB(B1, 1, 1); PG8_STAGE(PG8_SB(1, 0), b3, voffB);
            PG8_BAR; PG8_WAIT_L(0); PG8_MMA(0, 1, At, B1); PG8_BAR;
            PG8_LDA(At, 1, 1); PG8_STAGE(PG8_SA(1, 0), a3, voffA);
            PG8_BAR; PG8_WAIT_L(0); PG8_MMA(1, 0, At, B0); PG8_BAR; PG8_SCHED;
            PG8_STAGE(PG8_SB(1, 1), b3 + hstep, voffB);
            PG8_WAIT_V(6); PG8_BAR; PG8_MMA(1, 1, At, B1); PG8_BAR;
            }
        }
        if constexpr (ALIGN_EPI) { if (wr == 0) PG8_BAR; }
        if constexpr (!Epi::AFTER_DRAIN) { E(acc, cur, wr, wc, fr, fq); S.done(cur); }
        if (!has_next) break;
#pragma unroll
        for (int a = 0; a < 2; ++a)
#pragma unroll
            for (int b = 0; b < 2; ++b)
#pragma unroll
                for (int m = 0; m < 4; ++m)
#pragma unroll
                    for (int n = 0; n < 2; ++n) acc[a][b][m][n] = (f32x4){0.f, 0.f, 0.f, 0.f};
        cur = nxt; cA = nA; cB = nB; ++ui;
        if constexpr (ALIGN_EPI) { if (wr == 1) PG8_BAR; }
    }
    PG8_WAIT_V(0);
    if constexpr (!ALIGN_EPI) { if (wr == 0) PG8_BAR; }
    PG8_BAR;
    if constexpr (Epi::AFTER_DRAIN) { E.fused(acc, cur, wr, wc, fr, fq, lds, wid, lane); S.done(cur); }
#undef PG8_SA
#undef PG8_SB
#undef PG8_STAGE
#undef PG8_LDA
#undef PG8_LDB
#undef PG8_MMA
#undef PG8_WAIT_V
#undef PG8_WAIT_L
#undef PG8_BAR
#undef PG8_SCHED
}
}
constexpr int NWAVES = 8;
constexpr int NB = 4, SEQ = 4096, D = 1024, M = NB * SEQ;
constexpr int NH = 4, VD = 128, AW = 512, CWID = 512, CK = 31;
constexpr int NCOL = 4608;
constexpr int NE = 64, DE = 512;
constexpr float EPS = 1e-6f;
constexpr float LOG2E = 1.4426950408889634f;
constexpr float QSCALE = 0.125f * LOG2E;
constexpr int MAXTILES = 192;
constexpr int NPHASE = 10;

constexpr size_t MiB = 1u << 20;
constexpr size_t WS_CTL = 0, CTL_ZERO_BYTES = 1 * MiB;
constexpr size_t WS_WRF = 1 * MiB;
constexpr size_t WS_TOKINFO = 2 * MiB;
constexpr size_t WS_TOKSLOT = 2 * MiB + 512 * 1024;
constexpr size_t WS_ROWW = 2 * MiB + 768 * 1024;
constexpr size_t WS_WIN = 4 * MiB;
constexpr size_t WS_WMIX = 13 * MiB;
constexpr size_t WS_WOUT = 15 * MiB;
constexpr size_t WS_WGU = 17 * MiB;
constexpr size_t WS_WD = 145 * MiB;
constexpr size_t WS_B = 209 * MiB;
constexpr size_t WS_XN = WS_B + 0 * MiB;
constexpr size_t WS_Q = WS_B + 32 * MiB;
constexpr size_t WS_K = WS_B + 48 * MiB;
constexpr size_t WS_V = WS_B + 64 * MiB;
constexpr size_t WS_U = WS_B + 80 * MiB;
constexpr size_t WS_G = WS_B + 96 * MiB;
constexpr size_t WS_AO = WS_B + 160 * MiB;
constexpr size_t WS_UC = WS_B + 176 * MiB;
constexpr size_t WS_MG = WS_B + 192 * MiB;
constexpr size_t WS_T = WS_B + 0 * MiB;
constexpr size_t WS_XG = WS_B + 0 * MiB;
constexpr size_t WS_ACT = WS_B + 96 * MiB;
constexpr size_t WS_Y = WS_B + 144 * MiB;
constexpr size_t WS_END = WS_B + 240 * MiB;
constexpr int CW_BAR = 4096;
constexpr int CW_GCNT = 8192;

constexpr int RING_OFF = 0, RING_BYTES = 131072;
constexpr int LDSCTL_OFF = 155648;
constexpr int ATT_TAB_OFF = LDSCTL_OFF + 512;
constexpr int MOE_TAB_OFF = LDSCTL_OFF + 4096;
constexpr int LDS_BYTES = 163840;

#define GAS __attribute__((address_space(1)))
#define LAS __attribute__((address_space(3)))
typedef unsigned short bf16;
typedef unsigned v4u __attribute__((ext_vector_type(4)));
typedef unsigned v2u __attribute__((ext_vector_type(2)));
typedef float f32x4 __attribute__((ext_vector_type(4)));
typedef float f32x16 __attribute__((ext_vector_type(16)));
typedef short bf16x8 __attribute__((ext_vector_type(8)));
typedef short s16x4 __attribute__((ext_vector_type(4)));
typedef GAS unsigned gu32;
#define RLX_AGENT __ATOMIC_RELAXED, __HIP_MEMORY_SCOPE_AGENT
#define LDS_WAIT() asm volatile("s_waitcnt lgkmcnt(0)" ::: "memory")
#define VM_WAIT() asm volatile("s_waitcnt vmcnt(0)" ::: "memory")
typedef float f32x2_t __attribute__((ext_vector_type(2)));
typedef __bf16 bf16x2_t __attribute__((ext_vector_type(2)));
__device__ __forceinline__ unsigned pk2(float lo, float hi) { f32x2_t v = {lo, hi}; bf16x2_t b = __builtin_convertvector(v, bf16x2_t); return __builtin_bit_cast(unsigned, b); }
__device__ __forceinline__ float bf2f(unsigned short h) { return __uint_as_float((unsigned)h << 16); }
__device__ __forceinline__ float bflo(unsigned w) { return __uint_as_float(w << 16); }
__device__ __forceinline__ float bfhi(unsigned w) { return __uint_as_float(w & 0xffff0000u); }
__device__ __forceinline__ float sigmoidf_(float x) { return __builtin_amdgcn_rcpf(1.f + __expf(-x)); }
__device__ __forceinline__ float wave_sum(float v) {
#pragma unroll
    for (int o = 1; o < 64; o <<= 1) v += __shfl_xor(v, o);
    return v;
}
__device__ __forceinline__ float xhalf_max(float a) { auto rr = __builtin_amdgcn_permlane32_swap(__float_as_uint(a), __float_as_uint(a), false, false); return fmaxf(__uint_as_float(rr[0]), __uint_as_float(rr[1])); }
__device__ __forceinline__ float xhalf_sum(float a) { auto rr = __builtin_amdgcn_permlane32_swap(__float_as_uint(a), __float_as_uint(a), false, false); return __uint_as_float(rr[0]) + __uint_as_float(rr[1]); }
__device__ __forceinline__ int crow(int r, int hi) { return (r & 3) + 8 * (r >> 2) + 4 * hi; }

#define XB_TMO      128
#define XB_XCNT(j)  (256  + 64 * (j))
#define XB_XSUB(j)  (1280 + 64 * (j))
#define XB_XGEN(j)  (2304 + 64 * (j))
#define XB_TOP      3328
#define XB_TOPGEN   3392
#define XCD_BAR_WORDS 3456
#define XB_SPIN_CAP (1u << 18)

__device__ __forceinline__ unsigned xb_ld(unsigned* p)              { return __hip_atomic_load(p, __ATOMIC_RELAXED, __HIP_MEMORY_SCOPE_AGENT); }
__device__ __forceinline__ unsigned xb_add(unsigned* p, unsigned v) { return __hip_atomic_fetch_add(p, v, __ATOMIC_RELAXED, __HIP_MEMORY_SCOPE_AGENT); }
__device__ __forceinline__ unsigned xb_xcc_id() { return (unsigned)__builtin_amdgcn_s_getreg((3 << 11) | 20) & 0xFu; }
#define XB_SPIN(cond, bar) do { unsigned _sp = 0; while (cond) { __builtin_amdgcn_s_sleep(1); \
    if ((++_sp & 255u) == 0u) { if (xb_ld(&(bar)[XB_TMO])) break; if (_sp > XB_SPIN_CAP) { atomicAdd(&(bar)[XB_TMO], 1u); break; } } } } while (0)

struct XcdBarrier {
    unsigned* bar; unsigned x;
    volatile LAS unsigned* st;
};

__device__ __forceinline__ XcdBarrier xcd_barrier_post(unsigned* bar, volatile LAS unsigned* st) {
    XcdBarrier b; b.bar = bar; b.x = xb_xcc_id(); b.st = st;
    if (threadIdx.x == 0) (void)xb_add(&bar[XB_XCNT(b.x)], 1u);
    return b;
}
__device__ __forceinline__ void xcd_barrier_complete(unsigned* bar, unsigned x, unsigned& nloc, unsigned& nx) {
    const unsigned G = gridDim.x * gridDim.y * gridDim.z;
    unsigned sum, cnt, mine, sp = 0u;
    for (;;) {
        sum = 0u; cnt = 0u; mine = 0u;
#pragma unroll
        for (unsigned j = 0; j < 16; ++j) { const unsigned c = xb_ld(&bar[XB_XCNT(j)]); sum += c; cnt += (c > 0u) ? 1u : 0u; mine = (j == x) ? c : mine; }
        if (sum == G) break;
        __builtin_amdgcn_s_sleep(1);
        if ((++sp & 255u) == 0u) { if (xb_ld(&bar[XB_TMO])) break; if (sp > XB_SPIN_CAP) { atomicAdd(&bar[XB_TMO], 1u); break; } }
    }
    nloc = mine > 0u ? mine : 1u; nx = cnt > 0u ? cnt : 1u;
}

__device__ __forceinline__ void xcd_barrier(const XcdBarrier& b) {
    asm volatile("s_waitcnt vmcnt(0)" ::: "memory");
    __syncthreads();
    if (threadIdx.x == 0) {
        unsigned* bar = b.bar;
        __builtin_amdgcn_s_waitcnt(0);
        unsigned nloc = b.st[0], nx = b.st[1];
        if (nloc == 0u) { xcd_barrier_complete(bar, b.x, nloc, nx); b.st[0] = nloc; b.st[1] = nx; }
        const unsigned old = xb_add(&bar[XB_XSUB(b.x)], 1u);
        const unsigned gen = old / nloc;
        if (old + 1u == (gen + 1u) * nloc) {
            __builtin_amdgcn_fence(__ATOMIC_RELEASE, "agent");
            asm volatile("s_waitcnt vmcnt(0)" ::: "memory");
            const unsigned og = xb_add(&bar[XB_TOP], 1u);
            const unsigned tg = og / nx;
            if (og + 1u == (tg + 1u) * nx) xb_add(&bar[XB_TOPGEN], 1u);
            else XB_SPIN(xb_ld(&bar[XB_TOPGEN]) == tg, bar);
            __builtin_amdgcn_fence(__ATOMIC_ACQUIRE, "agent");
            xb_add(&bar[XB_XGEN(b.x)], 1u);
            asm volatile("s_waitcnt vmcnt(0)" ::: "memory");
        } else {
            XB_SPIN(xb_ld(&bar[XB_XGEN(b.x)]) == gen, bar);
            __builtin_amdgcn_fence(__ATOMIC_ACQUIRE, "agent");
            asm volatile("s_waitcnt vmcnt(0)" ::: "memory");
        }
    }
    __syncthreads();
}
#ifndef XP_IN_ATTN
#define XP_IN_ATTN 1
#endif

struct Frame {
    LAS unsigned char* lds;
    gu32* ctl;
    int tid, lane, wave;
    int vcu, G;
    const float *x, *w_in, *lq1, *lk1, *lq2, *lk2, *gsub, *relb, *w_au, *w_dw, *b_dw, *g_cln, *b_cln, *w_pw, *b_pw, *w_out, *g_mix, *g_ffn,
                *w_rg, *b_rg, *w_re, *b_re, *w_eg, *w_eu, *w_ed, *g_fin;
    float* out;
    bf16 *Win_t, *Wmix_t, *Wout_t, *Wgu_t, *Wd_t;
    bf16 *XN, *Qb, *Kb, *Vb, *U, *Gt, *AO, *UC, *MG, *XG, *ACT, *Y;
    float *T, *Wrf, *roww;
    int *tokinfo, *tokslot;
};

__device__ __forceinline__ int win_src_col(int pc) {
    if (pc < 1536 || pc >= 2560) return pc;
    const int t = (pc - 1536) >> 8, w = (pc - 1536) & 255, bj = w >> 7, i = w & 127;
    return 1536 + bj * 512 + t * 128 + i;
}
__device__ __forceinline__ void tr_tile(const float* src, int ldn, int k0, int c0, bf16* dst, int K, size_t r0, LAS unsigned* scr, int lane) {
    const int n4 = (lane & 15) * 4, kr = lane >> 4;
    f32x4 a[8], b[8];
#pragma unroll
    for (int i = 0; i < 8; ++i) { const int kp = 4 * i + kr;
        a[i] = *(const GAS f32x4*)(src + (size_t)(k0 + 2 * kp) * ldn + c0 + n4);
        b[i] = *(const GAS f32x4*)(src + (size_t)(k0 + 2 * kp + 1) * ldn + c0 + n4); }
#pragma unroll
    for (int i = 0; i < 8; ++i) { const int kp = 4 * i + kr;
        scr[(n4 + 0) * 33 + kp] = pk2(a[i].x, b[i].x); scr[(n4 + 1) * 33 + kp] = pk2(a[i].y, b[i].y);
        scr[(n4 + 2) * 33 + kp] = pk2(a[i].z, b[i].z); scr[(n4 + 3) * 33 + kp] = pk2(a[i].w, b[i].w); }
    LDS_WAIT(); asm volatile("" ::: "memory");
#pragma unroll
    for (int jj = 0; jj < 8; ++jj) { const int n = (lane >> 3) + 8 * jj, ch = lane & 7;
        v4u o; o.x = scr[n * 33 + ch * 4 + 0]; o.y = scr[n * 33 + ch * 4 + 1]; o.z = scr[n * 33 + ch * 4 + 2]; o.w = scr[n * 33 + ch * 4 + 3];
        *(GAS v4u*)(dst + (r0 + n) * (size_t)K + k0 + ch * 8) = o; }
    LDS_WAIT(); asm volatile("" ::: "memory");
}
__device__ __forceinline__ void p0_prologue(Frame& F) {
    LAS unsigned* scr = (LAS unsigned*)(F.lds + RING_OFF + F.wave * 8704);
    const int gw = F.vcu * NWAVES + F.wave, NGW = F.G * NWAVES, lane = F.lane;
    constexpr int I_IN = 16 * 72, I_AU = 8 * 16, I_PW = 8 * 16, I_OUT = 16 * 16, I_EXP = 384;
    constexpr int NITEMS = I_IN + I_AU + I_PW + I_OUT + (XP_IN_ATTN ? 0 : NE * I_EXP);
    for (int it = gw; it < NITEMS; it += NGW) {
        int r = it;
        if (r < I_IN) { const int kt = r / 72, rt = r % 72; tr_tile(F.w_in, NCOL, kt * 64, win_src_col(rt * 64), F.Win_t, 1024, (size_t)rt * 64, scr, lane); continue; } r -= I_IN;
        if (r < I_AU) { const int kt = r / 16, rt = r % 16; tr_tile(F.w_au, 1024, kt * 64, rt * 64, F.Wmix_t, 512, (size_t)rt * 64, scr, lane); continue; } r -= I_AU;
        if (r < I_PW) { const int kt = r / 16, rt = r % 16; tr_tile(F.w_pw, 1024, kt * 64, rt * 64, F.Wmix_t, 512, (size_t)1024 + rt * 64, scr, lane); continue; } r -= I_PW;
        if (r < I_OUT) { const int kt = r / 16, rt = r % 16; tr_tile(F.w_out, 1024, kt * 64, rt * 64, F.Wout_t, 1024, (size_t)rt * 64, scr, lane); continue; } r -= I_OUT;
        const int e = r / I_EXP; r -= e * I_EXP;
        if (r < 256) {
            const int bj = r >> 7, q = r & 127, kt = q >> 3, ct = q & 7, c0 = ct * 64;
            const float* src = (bj ? F.w_eu : F.w_eg) + (size_t)e * 1024 * 512;
            tr_tile(src, 512, kt * 64, c0, F.Wgu_t, 1024, (size_t)e * 1024 + (c0 >> 7) * 256 + bj * 128 + (c0 & 127), scr, lane);
        } else {
            const int q = r - 256, kt = q >> 4, ct = q & 15;
            tr_tile(F.w_ed + (size_t)e * 512 * 1024, 1024, kt * 64, ct * 64, F.Wd_t, 512, (size_t)e * 1024 + ct * 64, scr, lane);
        }
    }
    for (int m = gw; m < M; m += NGW) {
        const GAS f32x4* xr = (const GAS f32x4*)(F.x + (size_t)m * D) + lane; const GAS f32x4* gr = (const GAS f32x4*)F.g_mix + lane;
        f32x4 v[4]; float s = 0.f;
#pragma unroll
        for (int j = 0; j < 4; ++j) { v[j] = xr[64 * j]; s += (v[j].x * v[j].x + v[j].y * v[j].y) + (v[j].z * v[j].z + v[j].w * v[j].w); }
        const float rs = rsqrtf(wave_sum(s) * (1.f / D) + EPS);
        GAS v2u* o8 = (GAS v2u*)(F.XN + (size_t)m * D) + lane;
#pragma unroll
        for (int j = 0; j < 4; ++j) { const f32x4 g = gr[64 * j]; v2u o; o.x = pk2(v[j].x * rs * g.x, v[j].y * rs * g.y); o.y = pk2(v[j].z * rs * g.z, v[j].w * rs * g.w); o8[64 * j] = o; }
    }
    for (int i = F.vcu * 512 + F.tid; i < 64 * 5 * 64 * 4; i += F.G * 512) {
        const int j = i & 3, l = (i >> 2) & 63, q = i >> 8, ct = q % 5, kc = q / 5;
        const int k = kc * 16 + 4 * (l >> 4) + j, c = ct * 16 + (l & 15);
        float wv = 0.f; if (c < 8) wv = F.w_rg[k * 8 + c]; else if (c < 72) wv = F.w_re[k * 64 + (c - 8)];
        F.Wrf[i] = wv * F.g_ffn[k];
    }
}

using pg8::Unit;
struct EpiProj {
    static constexpr bool PERM = true, AFTER_DRAIN = false;
    bf16 *Q, *K, *V, *U, *G;
    __device__ __forceinline__ void operator()(const f32x4 (&acc)[2][2][4][2], const Unit& u, int wr, int wc, int fr, int fq) const {
        int row0 = u.pm * 256 + wr * 64 + fr; const int pn = u.pn;
        asm volatile("" : "+v"(row0), "+v"(fq));
        if (pn < 6) {
            bf16* base = Q + (size_t)(pn >> 1) * ((size_t)M * 512); const float sc = pn < 2 ? QSCALE : 1.f;
            const int col0 = (pn & 1) * 256 + wc * 32 + 8 * fq;
#pragma unroll
            for (int ai = 0; ai < 2; ++ai)
#pragma unroll
                for (int m = 0; m < 4; ++m) { bf16* rowp = base + (size_t)(row0 + ai * 128 + m * 16) * 512 + col0;
#pragma unroll
                    for (int bj = 0; bj < 2; ++bj) { const f32x4 v0 = acc[ai][bj][m][0] * sc, v1 = acc[ai][bj][m][1] * sc; v4u w;
                        w.x = pk2(v0[0], v0[1]); w.y = pk2(v0[2], v0[3]); w.z = pk2(v1[0], v1[1]); w.w = pk2(v1[2], v1[3]);
                        *(v4u*)(rowp + bj * 128) = w; } }
        } else if (pn < 10) {
            const int col0 = (pn - 6) * 128 + wc * 32 + 8 * fq;
#pragma unroll
            for (int ai = 0; ai < 2; ++ai)
#pragma unroll
                for (int m = 0; m < 4; ++m) { bf16* rowp = U + (size_t)(row0 + ai * 128 + m * 16) * 512 + col0;
                    const f32x4 a0 = acc[ai][0][m][0], a1 = acc[ai][0][m][1], b0 = acc[ai][1][m][0], b1 = acc[ai][1][m][1]; v4u w;
                    w.x = pk2(a0[0] * sigmoidf_(b0[0]), a0[1] * sigmoidf_(b0[1])); w.y = pk2(a0[2] * sigmoidf_(b0[2]), a0[3] * sigmoidf_(b0[3]));
                    w.z = pk2(a1[0] * sigmoidf_(b1[0]), a1[1] * sigmoidf_(b1[1])); w.w = pk2(a1[2] * sigmoidf_(b1[2]), a1[3] * sigmoidf_(b1[3]));
                    *(v4u*)rowp = w; }
        } else {
            const int col0 = (pn - 10) * 256 + wc * 32 + 8 * fq;
#pragma unroll
            for (int ai = 0; ai < 2; ++ai)
#pragma unroll
                for (int m = 0; m < 4; ++m) { bf16* rowp = G + (size_t)(row0 + ai * 128 + m * 16) * 2048 + col0;
#pragma unroll
                    for (int bj = 0; bj < 2; ++bj) { const f32x4 v0 = acc[ai][bj][m][0], v1 = acc[ai][bj][m][1]; v4u w;
                        w.x = pk2(sigmoidf_(v0[0]), sigmoidf_(v0[1])); w.y = pk2(sigmoidf_(v0[2]), sigmoidf_(v0[3]));
                        w.z = pk2(sigmoidf_(v1[0]), sigmoidf_(v1[1])); w.w = pk2(sigmoidf_(v1[2]), sigmoidf_(v1[3]));
                        *(v4u*)(rowp + bj * 128) = w; } }
        }
    }
};
struct EpiMerge {
    static constexpr bool PERM = true, AFTER_DRAIN = false;
    const bf16* G; const float* bpw; bf16* MG;
    __device__ __forceinline__ void operator()(const f32x4 (&acc)[2][2][4][2], const Unit& u, int wr, int wc, int fr, int fq) const {
        const bool sub = u.pm >= 64; const int pm = u.pm & 63, pn = u.pn & 3;
        int row0 = pm * 256 + wr * 64 + fr, col0 = pn * 256 + wc * 32 + 8 * fq;
        asm volatile("" : "+v"(row0), "+v"(col0));
        if (!sub) {
#pragma unroll
            for (int ai = 0; ai < 2; ++ai)
#pragma unroll
                for (int m = 0; m < 4; ++m) { const size_t rr = (size_t)(row0 + ai * 128 + m * 16); const bf16* gp = G + rr * 2048 + col0; bf16* op = MG + rr * 1024 + col0;
#pragma unroll
                    for (int bj = 0; bj < 2; ++bj) { const v4u g = *(const v4u*)(gp + bj * 128); const f32x4 v0 = acc[ai][bj][m][0], v1 = acc[ai][bj][m][1]; v4u w;
                        w.x = pk2(v0[0] * bflo(g.x), v0[1] * bfhi(g.x)); w.y = pk2(v0[2] * bflo(g.y), v0[3] * bfhi(g.y));
                        w.z = pk2(v1[0] * bflo(g.z), v1[1] * bfhi(g.z)); w.w = pk2(v1[2] * bflo(g.w), v1[3] * bfhi(g.w));
                        *(v4u*)(op + bj * 128) = w; } }
        } else {
            f32x4 bv[2][2];
#pragma unroll
            for (int bj = 0; bj < 2; ++bj) { bv[bj][0] = *(const f32x4*)(bpw + col0 + bj * 128); bv[bj][1] = *(const f32x4*)(bpw + col0 + bj * 128 + 4); }
#pragma unroll
            for (int ai = 0; ai < 2; ++ai)
#pragma unroll
                for (int m = 0; m < 4; ++m) { const size_t rr = (size_t)(row0 + ai * 128 + m * 16); const bf16* gp = G + rr * 2048 + 1024 + col0; bf16* op = MG + rr * 1024 + col0;
#pragma unroll
                    for (int bj = 0; bj < 2; ++bj) { const v4u g = *(const v4u*)(gp + bj * 128); const v4u t = *(const v4u*)(op + bj * 128);
                        const f32x4 v0 = acc[ai][bj][m][0] + bv[bj][0], v1 = acc[ai][bj][m][1] + bv[bj][1]; v4u w;
                        w.x = pk2(bflo(t.x) + v0[0] * bflo(g.x), bfhi(t.x) + v0[1] * bfhi(g.x)); w.y = pk2(bflo(t.y) + v0[2] * bflo(g.y), bfhi(t.y) + v0[3] * bfhi(g.y));
                        w.z = pk2(bflo(t.z) + v1[0] * bflo(g.z), bfhi(t.z) + v1[1] * bfhi(g.z)); w.w = pk2(bflo(t.w) + v1[2] * bflo(g.w), bfhi(t.w) + v1[3] * bfhi(g.w));
                        *(v4u*)(op + bj * 128) = w; } }
        }
    }
};
struct PairOrder {
    pg8::StaticOrder so;
    __device__ __forceinline__ bool next(int i, Unit& u) const { Unit b; if (!so.next(i >> 1, b)) return false; const int sub = i & 1; u.pm = b.pm + 64 * sub; u.pn = b.pn + 4 * sub; return true; }
    __device__ __forceinline__ void a_ready(const Unit&) const {}
    __device__ __forceinline__ void done(const Unit&) const {}
};
struct EpiX1 {
    static constexpr bool PERM = false, AFTER_DRAIN = false;
    const float* X; float* O;
    __device__ __forceinline__ void operator()(const f32x4 (&acc)[2][2][4][2], const Unit& u, int wr, int wc, int fr, int fq) const {
        int row0 = u.pm * 256 + wr * 64 + fr, col0 = u.pn * 256 + wc * 32 + 4 * fq;
        asm volatile("" : "+v"(row0), "+v"(col0));
#pragma unroll
        for (int ai = 0; ai < 2; ++ai)
#pragma unroll
            for (int m = 0; m < 4; ++m) { const size_t off = (size_t)(row0 + ai * 128 + m * 16) * D + col0;
#pragma unroll
                for (int bj = 0; bj < 2; ++bj)
#pragma unroll
                    for (int n = 0; n < 2; ++n) { const f32x4 xv = *(const f32x4*)(X + off + bj * 128 + n * 16); *(f32x4*)(O + off + bj * 128 + n * 16) = xv + acc[ai][bj][m][n]; } }
    }
};
struct EpiSwiglu {
    static constexpr bool PERM = true, AFTER_DRAIN = false;
    bf16* ACT;
    __device__ __forceinline__ void operator()(const f32x4 (&acc)[2][2][4][2], const Unit& u, int wr, int wc, int fr, int fq) const {
        int row0 = u.pm * 256 + wr * 64 + fr, col0 = (u.pn & 3) * 128 + wc * 32 + 8 * fq;
        asm volatile("" : "+v"(row0), "+v"(col0));
#pragma unroll
        for (int ai = 0; ai < 2; ++ai)
#pragma unroll
            for (int m = 0; m < 4; ++m) { bf16* rowp = ACT + (size_t)(row0 + ai * 128 + m * 16) * 512 + col0;
                const f32x4 a0 = acc[ai][0][m][0], a1 = acc[ai][0][m][1], b0 = acc[ai][1][m][0], b1 = acc[ai][1][m][1]; v4u w;
                w.x = pk2(a0[0] * sigmoidf_(a0[0]) * b0[0], a0[1] * sigmoidf_(a0[1]) * b0[1]); w.y = pk2(a0[2] * sigmoidf_(a0[2]) * b0[2], a0[3] * sigmoidf_(a0[3]) * b0[3]);
                w.z = pk2(a1[0] * sigmoidf_(a1[0]) * b1[0], a1[1] * sigmoidf_(a1[1]) * b1[1]); w.w = pk2(a1[2] * sigmoidf_(a1[2]) * b1[2], a1[3] * sigmoidf_(a1[3]) * b1[3]);
                *(v4u*)rowp = w; }
    }
};
struct EpiDown {
    static constexpr bool PERM = true, AFTER_DRAIN = false;
    bf16* Y; const float* roww;
    __device__ __forceinline__ void operator()(const f32x4 (&acc)[2][2][4][2], const Unit& u, int wr, int wc, int fr, int fq) const {
        int row0 = u.pm * 256 + wr * 64 + fr, col0 = (u.pn & 3) * 256 + wc * 32 + 8 * fq;
        asm volatile("" : "+v"(row0), "+v"(col0));
#pragma unroll
        for (int ai = 0; ai < 2; ++ai)
#pragma unroll
            for (int m = 0; m < 4; ++m) { const int rr = row0 + ai * 128 + m * 16; const float sc = roww[rr]; bf16* rowp = Y + (size_t)rr * 1024 + col0;
#pragma unroll
                for (int bj = 0; bj < 2; ++bj) { const f32x4 v0 = acc[ai][bj][m][0] * sc, v1 = acc[ai][bj][m][1] * sc; v4u w;
                    w.x = pk2(v0[0], v0[1]); w.y = pk2(v0[2], v0[3]); w.z = pk2(v1[0], v1[1]); w.w = pk2(v1[2], v1[3]);
                    *(v4u*)(rowp + bj * 128) = w; } }
    }
};
struct MoeOrder {
    const LAS int* te; int ntile, G, c;
    __device__ __forceinline__ bool next(int i, Unit& u) const { const int L = i * G + c; if (L >= ntile * 4) return false; const int mt = L >> 2; u.pm = mt; u.pn = te[mt] * 4 + (L & 3); return true; }
    __device__ __forceinline__ void a_ready(const Unit&) const {}
    __device__ __forceinline__ void done(const Unit&) const {}
};
__device__ __forceinline__ void moe_tables(Frame& F) {
    LAS int* tab = (LAS int*)(F.lds + MOE_TAB_OFF);
    __syncthreads();
    if (F.tid < NE) tab[F.tid] = (int)__hip_atomic_load(F.ctl + CW_GCNT + 64 * F.tid, RLX_AGENT);
    __syncthreads();
    if (F.tid == 0) { int pt = 0;
        for (int e = 0; e < NE; ++e) { tab[64 + e] = pt; const int nt = (tab[e] + 255) >> 8; for (int k = 0; k < nt; ++k) tab[129 + pt + k] = e; pt += nt; }
        tab[64 + NE] = pt; tab[129 + MAXTILES] = pt; }
    __syncthreads();
}

__device__ __forceinline__ void conv_unit(Frame& F, int unit) {
    LAS unsigned char* lds = F.lds + RING_OFF;
    const int tid = F.tid, lane = F.lane, w = F.wave;
    const int row0 = unit * 32, b = row0 / SEQ, t0 = row0 % SEQ;
#pragma unroll 1
    for (int hb = 0; hb < 2; ++hb) {   v4u sv[4];
#pragma unroll
        for (int it = 0; it < 4; ++it) { int p = tid + (hb * 4 + it) * 512; p = p < 62 * 64 ? p : 62 * 64 - 1; const int r = p >> 6, ch = p & 63; int t = t0 - 30 + r; t = t < 0 ? 0 : t;
            sv[it] = *(const GAS v4u*)(F.U + ((size_t)b * SEQ + t) * 512 + ch * 8); }
#pragma unroll
        for (int it = 0; it < 4; ++it) { const int p = tid + (hb * 4 + it) * 512; const int r = p >> 6, ch = p & 63; const int t = t0 - 30 + r;
            if (p < 62 * 64) *(LAS v4u*)(lds + r * 1024 + ch * 16) = t >= 0 ? sv[it] : (v4u){0u, 0u, 0u, 0u}; } }
    __syncthreads();
    {
        typedef float f32x2v __attribute__((ext_vector_type(2)));
        const int cp = tid & 255, rh = tid >> 8;
        f32x2v wt[CK];
#pragma unroll
        for (int j = 0; j < CK; ++j) wt[j] = *(const GAS f32x2v*)(F.w_dw + j * 512 + 2 * cp);
        const f32x2v bias = *(const GAS f32x2v*)(F.b_dw + 2 * cp);
        f32x2v a[16];
#pragma unroll
        for (int r = 0; r < 16; ++r) a[r] = bias;
        const LAS unsigned* in = (const LAS unsigned*)lds + (rh * 16) * 256 + cp;
#pragma unroll
        for (int i = 0; i < 46; ++i) { const unsigned xw = in[i * 256]; const f32x2v xv = (f32x2v){bflo(xw), bfhi(xw)};
#pragma unroll
            for (int r = 0; r < 16; ++r) { if (i - r >= 0 && i - r < CK) a[r] += wt[i - r] * xv; } }
        LAS f32x2v* yo = (LAS f32x2v*)(lds + 63488) + (rh * 16) * 256 + cp;
#pragma unroll
        for (int r = 0; r < 16; ++r) yo[r * 256] = a[r]; }
    __syncthreads();
    {   const f32x4 g0 = *(const GAS f32x4*)(F.g_cln + lane * 8), g1 = *(const GAS f32x4*)(F.g_cln + lane * 8 + 4), b0 = *(const GAS f32x4*)(F.b_cln + lane * 8), b1 = *(const GAS f32x4*)(F.b_cln + lane * 8 + 4);
#pragma unroll
        for (int k = 0; k < 4; ++k) { const int r = w * 4 + k; const LAS f32x4* yp = (const LAS f32x4*)(lds + 63488 + r * 2048) + lane * 2;
            f32x4 v0 = yp[0], v1 = yp[1];
            const float mean = wave_sum((v0.x + v0.y) + (v0.z + v0.w) + (v1.x + v1.y) + (v1.z + v1.w)) * (1.f / 512.f);
            v0 = v0 - mean; v1 = v1 - mean;
            const float var = wave_sum((v0.x * v0.x + v0.y * v0.y) + (v0.z * v0.z + v0.w * v0.w) + (v1.x * v1.x + v1.y * v1.y) + (v1.z * v1.z + v1.w * v1.w)) * (1.f / 512.f);
            const float rs = rsqrtf(var + EPS);
            v0 = v0 * rs * g0 + b0; v1 = v1 * rs * g1 + b1;
            v4u o; o.x = pk2(v0.x * sigmoidf_(v0.x), v0.y * sigmoidf_(v0.y)); o.y = pk2(v0.z * sigmoidf_(v0.z), v0.w * sigmoidf_(v0.w));
            o.z = pk2(v1.x * sigmoidf_(v1.x), v1.y * sigmoidf_(v1.y)); o.w = pk2(v1.z * sigmoidf_(v1.z), v1.w * sigmoidf_(v1.w));
            *(GAS v4u*)(F.UC + (size_t)(row0 + r) * 512 + lane * 8) = o; } }
    __syncthreads();
}

constexpr int XP_TILES = NE * 768;
constexpr int XP_SCR_OFF = 65536;
struct XpTile { const float* src; bf16* dst; int ldn, K, k0, c0; size_t r0; };
__device__ __forceinline__ XpTile xp_tile(const Frame& F, int T) {
    XpTile t; const int e = T / 768, r = T % 768;
    if (r < 512) { const int bj = r >> 8, q = r & 255, kt = q >> 4, ct = q & 15; t.c0 = ct * 32; t.k0 = kt * 64;
        t.src = (bj ? F.w_eu : F.w_eg) + (size_t)e * 1024 * 512; t.ldn = 512; t.dst = F.Wgu_t; t.K = 1024; t.r0 = (size_t)e * 1024 + (t.c0 >> 7) * 256 + bj * 128 + (t.c0 & 127); }
    else { const int q = r - 512, kt = q >> 5, ct = q & 31; t.c0 = ct * 32; t.k0 = kt * 64;
        t.src = F.w_ed + (size_t)e * 512 * 1024; t.ldn = 1024; t.dst = F.Wd_t; t.K = 512; t.r0 = (size_t)e * 1024 + t.c0; }
    return t;
}
#define XP_ISSUE(xi_) do { const int NGW_ = F.G * NWAVES; int T_ = F.vcu * NWAVES + F.wave + ((xi_) >> 1) * NGW_; T_ = T_ < XP_TILES ? T_ : XP_TILES - 1; const XpTile t_ = xp_tile(F, T_); \
        const float* p_ = t_.src + (size_t)(t_.k0 + 32 * ((xi_) & 1) + 2 * (F.lane >> 3)) * t_.ldn + t_.c0 + (F.lane & 7) * 4; \
        xa0 = *(const GAS f32x4*)p_; xb0 = *(const GAS f32x4*)(p_ + t_.ldn); xa1 = *(const GAS f32x4*)(p_ + (size_t)16 * t_.ldn); xb1 = *(const GAS f32x4*)(p_ + (size_t)17 * t_.ldn); } while (0)
#define XP_COMMIT(xi_) do { const int NGW_ = F.G * NWAVES; int T_ = F.vcu * NWAVES + F.wave + ((xi_) >> 1) * NGW_; const bool valid_ = T_ < XP_TILES; T_ = valid_ ? T_ : XP_TILES - 1; \
        LAS unsigned* scr_ = (LAS unsigned*)(F.lds + RING_OFF + XP_SCR_OFF + F.wave * 4224); const int n4_ = (F.lane & 7) * 4, kp_ = ((xi_) & 1) * 16 + (F.lane >> 3); \
        scr_[(n4_ + 0) * 33 + kp_] = pk2(xa0.x, xb0.x); scr_[(n4_ + 1) * 33 + kp_] = pk2(xa0.y, xb0.y); scr_[(n4_ + 2) * 33 + kp_] = pk2(xa0.z, xb0.z); scr_[(n4_ + 3) * 33 + kp_] = pk2(xa0.w, xb0.w); \
        scr_[(n4_ + 0) * 33 + kp_ + 8] = pk2(xa1.x, xb1.x); scr_[(n4_ + 1) * 33 + kp_ + 8] = pk2(xa1.y, xb1.y); scr_[(n4_ + 2) * 33 + kp_ + 8] = pk2(xa1.z, xb1.z); scr_[(n4_ + 3) * 33 + kp_ + 8] = pk2(xa1.w, xb1.w); \
        if ((xi_) & 1) { const XpTile t_ = xp_tile(F, T_); LDS_WAIT(); asm volatile("" ::: "memory"); \
            _Pragma("unroll") for (int jj_ = 0; jj_ < 4; ++jj_) { const int n_ = (F.lane >> 3) + 8 * jj_, ch_ = F.lane & 7; v4u o_; \
                o_.x = scr_[n_ * 33 + ch_ * 4 + 0]; o_.y = scr_[n_ * 33 + ch_ * 4 + 1]; o_.z = scr_[n_ * 33 + ch_ * 4 + 2]; o_.w = scr_[n_ * 33 + ch_ * 4 + 3]; \
                if (valid_) *(GAS v4u*)(t_.dst + (t_.r0 + n_) * (size_t)t_.K + t_.k0 + ch_ * 8) = o_; } \
            LDS_WAIT(); asm volatile("" ::: "memory"); } } while (0)

__device__ __forceinline__ int rel_bucket_dev(int d) {
    const int n = d < 0 ? -d : d; int v;
    if (n < 8) v = n; else if (n < 12) v = 8; else if (n < 16) v = 9; else if (n < 23) v = 10; else if (n < 32) v = 11; else if (n < 46) v = 12; else if (n < 64) v = 13; else if (n < 91) v = 14; else v = 15;
    return (d < 0 ? 16 : 0) + v;
}
__device__ __forceinline__ void attn_unit(Frame& F, int b, int h, int qi, float lam, int& xi, int xsteps) {
    LAS unsigned char* lds = F.lds + RING_OFF;
    const int tid = F.tid, lane = F.lane, w = F.wave, mp = w >> 2, rg = w & 3, r32 = lane & 31, hi = lane >> 5;
    const int q0 = qi * 128, qw0 = q0 + rg * 32, qrow = qw0 + r32;
    const size_t rowb = (size_t)b * SEQ;
    const int cw = qw0 >> 6, cmax = (q0 >> 6) + 1;
    LAS bf16x8* qfl = (LAS bf16x8*)(lds + 65536 + 8 * 4224 + w * 4096) + lane;
    {   const bf16* qp = F.Qb + (rowb + qrow) * 512 + h * 128 + mp * 64 + hi * 8;
#pragma unroll
        for (int d0 = 0; d0 < 4; ++d0) qfl[d0 * 64] = *(const GAS bf16x8*)(qp + d0 * 16); }
    const bf16* kg0; const bf16* kg1; const bf16* vg0; const bf16* vg1;
    {   const int key = 8 * w + (lane >> 3), cs = lane & 7, c = cs ^ ((key >> 1) & 7);
        kg0 = F.Kb + (rowb + key) * 512 + h * 128 + c * 8; kg1 = kg0 + 64;
        const int vk = 4 * w + (lane >> 4), vc = (lane & 15) ^ ((vk & 3) << 2);
        vg0 = F.Vb + (rowb + vk) * 512 + h * 128 + vc * 8; vg1 = vg0 + (size_t)32 * 512; }
    const unsigned ldsw = (unsigned)(size_t)(lds) + (unsigned)w * 1024u;
#define ATT_GLDS(gp_, dst_) do { unsigned keep_; asm volatile("s_mov_b32 %0, m0\n\ts_mov_b32 m0, %2\n\ts_nop 0\n\tglobal_load_lds_dwordx4 %1, off\n\ts_mov_b32 m0, %0" : "=&s"(keep_) : "v"(gp_), "s"(dst_) : "memory"); } while (0)
#define ATT_DMA(j, bf) do { const size_t go_ = (size_t)(j) * 64 * 512; const unsigned b_ = (unsigned)__builtin_amdgcn_readfirstlane((int)(ldsw + (unsigned)(bf) * 32768u)); \
        ATT_GLDS(kg0 + go_, b_); ATT_GLDS(kg1 + go_, b_ + 8192u); ATT_GLDS(vg0 + go_, b_ + 16384u); ATT_GLDS(vg1 + go_, b_ + 24576u); } while (0)
    ATT_DMA(0, 1); VM_WAIT();
    __syncthreads();
    f32x4 xa0, xb0, xa1, xb1;
    f32x16 o[4];
#pragma unroll
    for (int vb = 0; vb < 4; ++vb)
#pragma unroll
        for (int r = 0; r < 16; ++r) o[vb][r] = 0.f;
    float m_run = 0.f, l_run = 0.f;
    const LAS float* btab = (const LAS float*)(F.lds + ATT_TAB_OFF) + h * 192;
    const float c15 = btab[191];
    const int kfo = r32 * 128, ksw = (r32 >> 1) & 7;
    const int vsw = (lane & 15) >> 2;
    const int vrow = (4 * hi + vsw) * 256 + 32 * ((lane >> 4) & 1) + 8 * (lane & 3);
    for (int j = 0; j <= cmax; ++j) {
        const int buf = (j + 1) & 1;
        if (j < cmax) ATT_DMA(j + 1, j & 1);
        const bool xact = XP_IN_ATTN && xi < xsteps;
        if (xact) XP_ISSUE(xi);
        if (j <= cw) {
            const LAS unsigned char* kb = lds + buf * 32768 + mp * 8192;
            const LAS unsigned char* vbp = lds + buf * 32768 + 16384;
            const bool far = (64 * j + 154 <= qw0);
            f32x16 p0, p1;
#pragma unroll
            for (int r = 0; r < 16; ++r) { p0[r] = 0.f; p1[r] = 0.f; }
            {   bf16x8 ka[4], kc[4], qv[4];
#pragma unroll
                for (int d0 = 0; d0 < 4; ++d0) { const int off = kfo + (((d0 * 2 + hi) ^ ksw) << 4);
                    ka[d0] = *(const LAS bf16x8*)(kb + off); kc[d0] = *(const LAS bf16x8*)(kb + off + 4096); qv[d0] = qfl[d0 * 64]; }
#pragma unroll
                for (int d0 = 0; d0 < 4; ++d0) {
                    p0 = __builtin_amdgcn_mfma_f32_32x32x16_bf16(ka[d0], qv[d0], p0, 0, 0, 0);
                    p1 = __builtin_amdgcn_mfma_f32_32x32x16_bf16(kc[d0], qv[d0], p1, 0, 0, 0); } }
            if (!far) { const int dq = qrow - 64 * j + 63;
#pragma unroll
                for (int r = 0; r < 16; ++r) { const int kk = crow(r, hi); int i0 = dq - kk; i0 = i0 > 191 ? 191 : i0; int i1 = dq - kk - 32; i1 = i1 > 191 ? 191 : i1; p0[r] += btab[i0]; p1[r] += btab[i1]; } }
            float cc = (far ? c15 : 0.f) - m_run;
            float mx = fmaxf(p0[0], p1[0]);
#pragma unroll
            for (int r = 1; r < 16; ++r) mx = fmaxf(mx, fmaxf(p0[r], p1[r]));
            const float mxc = mx + cc;
            if (j == 0) { const float d = xhalf_max(mxc); m_run = d; cc -= d; }
            else if (__any(mxc > 8.f)) { const float d = fmaxf(xhalf_max(mxc), 0.f); m_run += d; cc -= d; const float alpha = __builtin_amdgcn_exp2f(-d); l_run *= alpha;
#pragma unroll
                for (int vb = 0; vb < 4; ++vb)
#pragma unroll
                    for (int r = 0; r < 16; ++r) o[vb][r] *= alpha; }
            p0 = p0 + cc; p1 = p1 + cc;
#pragma unroll
            for (int r = 0; r < 16; ++r) { p0[r] = __builtin_amdgcn_exp2f(p0[r]); p1[r] = __builtin_amdgcn_exp2f(p1[r]); }
            {   const f32x16 ps = p0 + p1; const float s01 = (ps[0] + ps[1]) + (ps[2] + ps[3]), s23 = (ps[4] + ps[5]) + (ps[6] + ps[7]), s45 = (ps[8] + ps[9]) + (ps[10] + ps[11]), s67 = (ps[12] + ps[13]) + (ps[14] + ps[15]);
                l_run += (s01 + s23) + (s45 + s67); }
            bf16x8 pf[4];
            {   v4u t;
                t.x = pk2(p0[0], p0[1]); t.y = pk2(p0[2], p0[3]); t.z = pk2(p0[4], p0[5]); t.w = pk2(p0[6], p0[7]); pf[0] = __builtin_bit_cast(bf16x8, t);
                t.x = pk2(p0[8], p0[9]); t.y = pk2(p0[10], p0[11]); t.z = pk2(p0[12], p0[13]); t.w = pk2(p0[14], p0[15]); pf[1] = __builtin_bit_cast(bf16x8, t);
                t.x = pk2(p1[0], p1[1]); t.y = pk2(p1[2], p1[3]); t.z = pk2(p1[4], p1[5]); t.w = pk2(p1[6], p1[7]); pf[2] = __builtin_bit_cast(bf16x8, t);
                t.x = pk2(p1[8], p1[9]); t.y = pk2(p1[10], p1[11]); t.z = pk2(p1[12], p1[13]); t.w = pk2(p1[14], p1[15]); pf[3] = __builtin_bit_cast(bf16x8, t); }
            {   s16x4 vl[2][4], vh[2][4];
#define ATT_VRD(vb_, set_) do { const LAS unsigned char* vp_ = vbp + vrow + (((vb_) ^ vsw) << 6); _Pragma("unroll") for (int ks_ = 0; ks_ < 4; ++ks_) { \
                    vl[set_][ks_] = __builtin_bit_cast(s16x4, __builtin_amdgcn_ds_read_tr16_b64_v4i16((LAS s16x4*)(vp_ + ks_ * 4096))); \
                    vh[set_][ks_] = __builtin_bit_cast(s16x4, __builtin_amdgcn_ds_read_tr16_b64_v4i16((LAS s16x4*)(vp_ + ks_ * 4096 + 2048))); } } while (0)
#define ATT_PV(vb_, set_) do { _Pragma("unroll") for (int ks_ = 0; ks_ < 4; ++ks_) { const s16x4 lo_ = vl[set_][ks_], hh_ = vh[set_][ks_]; \
                    const bf16x8 va_ = (bf16x8){lo_[0], lo_[1], lo_[2], lo_[3], hh_[0], hh_[1], hh_[2], hh_[3]}; o[vb_] = __builtin_amdgcn_mfma_f32_32x32x16_bf16(va_, pf[ks_], o[vb_], 0, 0, 0); } } while (0)
                ATT_VRD(0, 0); ATT_VRD(1, 1); ATT_PV(0, 0); ATT_VRD(2, 0); ATT_PV(1, 1); ATT_VRD(3, 1); ATT_PV(2, 0); ATT_PV(3, 1);
#undef ATT_VRD
#undef ATT_PV
            }
        }
        if (xact) { XP_COMMIT(xi); ++xi; }
        VM_WAIT();
        __syncthreads();
    }
#undef ATT_DMA
#undef ATT_GLDS
    const float inv = 1.f / xhalf_sum(l_run);
    LAS unsigned* X = (LAS unsigned*)lds + rg * 2048 + lane;
    if (mp == 1) {
#pragma unroll
        for (int vb = 0; vb < 4; ++vb)
#pragma unroll
            for (int r2 = 0; r2 < 8; ++r2) X[(vb * 8 + r2) * 64] = pk2(o[vb][2 * r2] * inv, o[vb][2 * r2 + 1] * inv); }
    __syncthreads();
    if (mp == 0) {
        float ss = 0.f;
#pragma unroll
        for (int vb = 0; vb < 4; ++vb)
#pragma unroll
            for (int r2 = 0; r2 < 8; ++r2) { const unsigned xw = X[(vb * 8 + r2) * 64];
                const float v0 = o[vb][2 * r2] * inv - lam * bflo(xw), v1 = o[vb][2 * r2 + 1] * inv - lam * bfhi(xw); o[vb][2 * r2] = v0; o[vb][2 * r2 + 1] = v1; ss += v0 * v0 + v1 * v1; }
        ss = xhalf_sum(ss);
        const float rs = rsqrtf(ss * (1.f / 128.f) + EPS) * 0.8f;
        int hi2 = hi; asm volatile("" : "+v"(hi2));
        bf16* op = F.AO + (rowb + qrow) * 512 + h * 128;
#pragma unroll
        for (int vb = 0; vb < 4; ++vb)
#pragma unroll
            for (int rq = 0; rq < 4; ++rq) { const int v0 = vb * 32 + 8 * rq + 4 * hi2; const f32x4 g = *(const GAS f32x4*)(F.gsub + v0); v2u ow;
                ow.x = pk2(o[vb][4 * rq + 0] * rs * g.x, o[vb][4 * rq + 1] * rs * g.y); ow.y = pk2(o[vb][4 * rq + 2] * rs * g.z, o[vb][4 * rq + 3] * rs * g.w);
                *(GAS v2u*)(op + v0) = ow; }
    }
}
__device__ __forceinline__ void p2_mixers(Frame& F) {
#ifdef DBG_NO_CONV
    for (size_t i = (size_t)blockIdx.x * 512 + F.tid; i < (size_t)M * 512 * 2 / 16; i += (size_t)F.G * 512) ((GAS v4u*)F.UC)[i] = (v4u){0u, 0u, 0u, 0u};
#else
#ifdef REP_CONV
    for (int rep = 0; rep < 2; ++rep)
#endif
    for (int u = F.vcu; u < M / 32; u += F.G) conv_unit(F, u);
#endif
    {   LAS float* bt = (LAS float*)(F.lds + ATT_TAB_OFF);
        for (int i = F.tid; i < NH * 192; i += 512) { const int h = i / 192, d = i % 192 - 63; bt[i] = F.relb[rel_bucket_dev(d) * NH + h] * LOG2E; } }
    int xi = 0; const int xsteps = 2 * ((XP_TILES + F.G * NWAVES - 1) / (F.G * NWAVES));
    float lam;
    {   const float a = wave_sum(F.lq1[F.lane] * F.lk1[F.lane]), c = wave_sum(F.lq2[F.lane] * F.lk2[F.lane]); lam = __expf(a) - __expf(c) + 0.2f; }
    __syncthreads();
#ifdef DBG_NO_ATT
    for (size_t i = (size_t)blockIdx.x * 512 + F.tid; i < (size_t)M * 512 * 2 / 16; i += (size_t)F.G * 512) ((GAS v4u*)F.AO)[i] = (v4u){0u, 0u, 0u, 0u};
    if (lam == 123.f) F.AO[0] = 1;
#else
#ifdef REP_ATT
    for (int rep = 0; rep < 2; ++rep)
#endif
    for (int v = F.vcu; v < 256; v += F.G) { const int bh = v >> 4, s = v & 15;
#pragma unroll 1
        for (int k = 0; k < 2; ++k) attn_unit(F, bh >> 2, bh & 3, k ? 31 - s : s, lam, xi, xsteps); }
#endif
    __syncthreads();
    if (XP_IN_ATTN) { f32x4 xa0, xb0, xa1, xb1; while (xi < xsteps) { XP_ISSUE(xi); XP_COMMIT(xi); ++xi; } }
    __syncthreads();
}

typedef float f32x4v __attribute__((ext_vector_type(4)));
__device__ __forceinline__ void p5a_router(Frame& F, bool dry) {
    LAS unsigned char* lds = F.lds + RING_OFF;
    LAS float* LP = (LAS float*)lds;
    LAS float* SS = (LAS float*)(lds + 40960);
    LAS int* lcnt = (LAS int*)(lds + 40960 + 512);
    LAS int* lbase = (LAS int*)(lds + 40960 + 768);
    const int tid = F.tid, lane = F.lane, w = F.wave, rt = w & 3, kh = w >> 2, r16 = lane & 15, kq = lane >> 4;
    for (int blk = F.vcu; blk < M / 64; blk += F.G) {
        if (tid < 64) lcnt[tid] = 0;
        {   const int row = blk * 64 + rt * 16 + r16;
            const float* xp = F.out + (size_t)row * D + kh * 512 + 4 * kq;
            const GAS f32x4* wf = (const GAS f32x4*)F.Wrf + (size_t)(kh * 32) * 5 * 64 + lane;
            f32x4 acc[5]; float ss = 0.f;
#pragma unroll
            for (int ct = 0; ct < 5; ++ct) acc[ct] = (f32x4){0.f, 0.f, 0.f, 0.f};
#pragma unroll 4
            for (int kc = 0; kc < 32; ++kc) {
                const f32x4 a = *(const GAS f32x4*)(xp + kc * 16);
                f32x4 bw[5];
#pragma unroll
                for (int ct = 0; ct < 5; ++ct) bw[ct] = wf[(kc * 5 + ct) * 64];
                ss += (a.x * a.x + a.y * a.y) + (a.z * a.z + a.w * a.w);
#pragma unroll
                for (int ct = 0; ct < 5; ++ct) {
                    acc[ct] = __builtin_amdgcn_mfma_f32_16x16x4f32(a.x, bw[ct].x, acc[ct], 0, 0, 0);
                    acc[ct] = __builtin_amdgcn_mfma_f32_16x16x4f32(a.y, bw[ct].y, acc[ct], 0, 0, 0);
                    acc[ct] = __builtin_amdgcn_mfma_f32_16x16x4f32(a.z, bw[ct].z, acc[ct], 0, 0, 0);
                    acc[ct] = __builtin_amdgcn_mfma_f32_16x16x4f32(a.w, bw[ct].w, acc[ct], 0, 0, 0); }
            }
            ss += __shfl_xor(ss, 16); ss += __shfl_xor(ss, 32);
            if (kq == 0) SS[kh * 64 + rt * 16 + r16] = ss;
#pragma unroll
            for (int ct = 0; ct < 5; ++ct)
#pragma unroll
                for (int rg = 0; rg < 4; ++rg) LP[(kh * 64 + rt * 16 + 4 * kq + rg) * 80 + ct * 16 + r16] = acc[ct][rg];
        }
        __syncthreads();
        int e0 = 0, e1 = 0, rk0 = 0, rk1 = 0; float w0 = 0.f, w1 = 0.f, rstd = 0.f;
        if (tid < 64) {
            const int r = tid; const LAS float* l0 = LP + r * 80; const LAS float* l1 = LP + (64 + r) * 80;
            rstd = rsqrtf((SS[r] + SS[64 + r]) * (1.f / D) + EPS);
            float lg[8]; int grp = 0; float mx = -3.0e38f;
#pragma unroll
            for (int g = 0; g < 8; ++g) { lg[g] = (l0[g] + l1[g]) * rstd + F.b_rg[g]; if (lg[g] > mx) { mx = lg[g]; grp = g; } }
            float den = 0.f;
#pragma unroll
            for (int g = 0; g < 8; ++g) den += __expf(lg[g] - mx);
            const float pg = 1.f / den;
            float v0 = -3.0e38f, v1 = -3.0e38f; int j0 = 0, j1 = 0;
            for (int j = 0; j < 8; ++j) { const float le = (l0[8 + grp * 8 + j] + l1[8 + grp * 8 + j]) * rstd + F.b_re[grp * 8 + j];
                if (le > v0) { v1 = v0; j1 = j0; v0 = le; j0 = j; } else if (le > v1) { v1 = le; j1 = j; } }
            w0 = pg / (1.f + __expf(v1 - v0)); w1 = pg - w0;
            e0 = grp * 8 + j0; e1 = grp * 8 + j1;
            rk0 = __hip_atomic_fetch_add(lcnt + e0, 1, __ATOMIC_RELAXED, __HIP_MEMORY_SCOPE_WORKGROUP);
            rk1 = __hip_atomic_fetch_add(lcnt + e1, 1, __ATOMIC_RELAXED, __HIP_MEMORY_SCOPE_WORKGROUP);
        }
        __syncthreads();
        if (tid < 64) { const int c = lcnt[tid]; lbase[tid] = (c > 0 && !dry) ? (int)__hip_atomic_fetch_add(F.ctl + CW_GCNT + 64 * tid, (unsigned)c, RLX_AGENT) : 0; }
        __syncthreads();
        if (tid < 64) { int* ti = F.tokinfo + (size_t)(blk * 64 + tid) * 8;
            ti[0] = e0; ti[1] = e1; ti[2] = lbase[e0] + rk0; ti[3] = lbase[e1] + rk1; ti[4] = __float_as_int(w0); ti[5] = __float_as_int(w1); ti[6] = __float_as_int(rstd); ti[7] = 0; }
        __syncthreads();
    }
}
__device__ __forceinline__ void p5b_gather(Frame& F) {
    moe_tables(F);
    const LAS int* tab = (const LAS int*)(F.lds + MOE_TAB_OFF);
    LAS int* rowinfo = (LAS int*)(F.lds + RING_OFF);
    const int tid = F.tid, lane = F.lane, w = F.wave;
    for (int blk = F.vcu; blk < M / 64; blk += F.G) {
        if (tid < 64) { const int t = blk * 64 + tid; const int* ti = F.tokinfo + (size_t)t * 8;
            const int e0 = ti[0], e1 = ti[1]; const int s0 = tab[64 + e0] * 256 + ti[2], s1 = tab[64 + e1] * 256 + ti[3];
            F.tokslot[2 * t] = s0; F.tokslot[2 * t + 1] = s1; F.roww[s0] = __int_as_float(ti[4]); F.roww[s1] = __int_as_float(ti[5]);
            rowinfo[tid * 4 + 0] = s0; rowinfo[tid * 4 + 1] = s1; rowinfo[tid * 4 + 2] = ti[6]; }
        __syncthreads();
        for (int k = 0; k < 8; k += 2) {
            f32x4 xa[2][2][2]; int sl[2][2]; float rsd[2];
#pragma unroll
            for (int q = 0; q < 2; ++q) { const int r = w * 8 + k + q, t = blk * 64 + r; sl[q][0] = rowinfo[r * 4]; sl[q][1] = rowinfo[r * 4 + 1]; rsd[q] = __int_as_float(rowinfo[r * 4 + 2]);
                const float* xr = F.out + (size_t)t * D;
#pragma unroll
                for (int hf = 0; hf < 2; ++hf) { const int c = hf * 512 + lane * 8; xa[q][hf][0] = *(const GAS f32x4*)(xr + c); xa[q][hf][1] = *(const GAS f32x4*)(xr + c + 4); } }
#pragma unroll
            for (int hf = 0; hf < 2; ++hf) { const int c = hf * 512 + lane * 8; const f32x4 ga = *(const GAS f32x4*)(F.g_ffn + c), gb = *(const GAS f32x4*)(F.g_ffn + c + 4);
#pragma unroll
                for (int q = 0; q < 2; ++q) { const f32x4 a = xa[q][hf][0] * rsd[q] * ga, b = xa[q][hf][1] * rsd[q] * gb; v4u o;
                    o.x = pk2(a.x, a.y); o.y = pk2(a.z, a.w); o.z = pk2(b.x, b.y); o.w = pk2(b.z, b.w);
                    *(GAS v4u*)(F.XG + (size_t)sl[q][0] * D + c) = o; *(GAS v4u*)(F.XG + (size_t)sl[q][1] * D + c) = o; } } }
        __syncthreads();
    }
}
__device__ __forceinline__ void p8_final(Frame& F, float* dstbase) {
    const int gw = F.vcu * NWAVES + F.wave, NGW = F.G * NWAVES, lane = F.lane;
    const GAS f32x4* gr = (const GAS f32x4*)F.g_fin + lane;
    for (int m0 = gw; m0 < M; m0 += 2 * NGW) {
        const int m1 = m0 + NGW < M ? m0 + NGW : m0;
        const int sa0 = F.tokslot[2 * m0], sa1 = F.tokslot[2 * m0 + 1], sb0 = F.tokslot[2 * m1], sb1 = F.tokslot[2 * m1 + 1];
        const GAS f32x4* xa = (const GAS f32x4*)(F.out + (size_t)m0 * D) + lane; const GAS f32x4* xb = (const GAS f32x4*)(F.out + (size_t)m1 * D) + lane;
        const GAS v2u* ya0 = (const GAS v2u*)(F.Y + (size_t)sa0 * D) + lane; const GAS v2u* ya1 = (const GAS v2u*)(F.Y + (size_t)sa1 * D) + lane;
        const GAS v2u* yb0 = (const GAS v2u*)(F.Y + (size_t)sb0 * D) + lane; const GAS v2u* yb1 = (const GAS v2u*)(F.Y + (size_t)sb1 * D) + lane;
        f32x4 va[4], vb[4]; v2u pa[4], qa[4], pb[4], qb[4];
#pragma unroll
        for (int j = 0; j < 4; ++j) { va[j] = xa[64 * j]; pa[j] = ya0[64 * j]; qa[j] = ya1[64 * j]; vb[j] = xb[64 * j]; pb[j] = yb0[64 * j]; qb[j] = yb1[64 * j]; }
        float s0 = 0.f, s1 = 0.f;
#pragma unroll
        for (int j = 0; j < 4; ++j) {
            va[j].x += bflo(pa[j].x) + bflo(qa[j].x); va[j].y += bfhi(pa[j].x) + bfhi(qa[j].x); va[j].z += bflo(pa[j].y) + bflo(qa[j].y); va[j].w += bfhi(pa[j].y) + bfhi(qa[j].y);
            vb[j].x += bflo(pb[j].x) + bflo(qb[j].x); vb[j].y += bfhi(pb[j].x) + bfhi(qb[j].x); vb[j].z += bflo(pb[j].y) + bflo(qb[j].y); vb[j].w += bfhi(pb[j].y) + bfhi(qb[j].y);
            s0 += (va[j].x * va[j].x + va[j].y * va[j].y) + (va[j].z * va[j].z + va[j].w * va[j].w);
            s1 += (vb[j].x * vb[j].x + vb[j].y * vb[j].y) + (vb[j].z * vb[j].z + vb[j].w * vb[j].w); }
        const float r0 = rsqrtf(wave_sum(s0) * (1.f / D) + EPS), r1 = rsqrtf(wave_sum(s1) * (1.f / D) + EPS);
        GAS f32x4* oa = (GAS f32x4*)(dstbase + (size_t)m0 * D) + lane; GAS f32x4* ob = (GAS f32x4*)(dstbase + (size_t)m1 * D) + lane;
#pragma unroll
        for (int j = 0; j < 4; ++j) { const f32x4 g = gr[64 * j];
            oa[64 * j] = (f32x4){va[j].x * r0 * g.x, va[j].y * r0 * g.y, va[j].z * r0 * g.z, va[j].w * r0 * g.w};
            if (m1 != m0) ob[64 * j] = (f32x4){vb[j].x * r1 * g.x, vb[j].y * r1 * g.y, vb[j].z * r1 * g.z, vb[j].w * r1 * g.w}; }
    }
}

struct Args { const float* in[26]; float* out; unsigned char* ws; int ph_lo, ph_hi; };
__global__ void __launch_bounds__(NWAVES * 64, 2) fwd_kernel(Args args) {
    extern __shared__ __attribute__((aligned(16))) unsigned char lds[];
    Frame F;
    F.lds = (LAS unsigned char*)lds;
    F.tid = threadIdx.x; F.lane = F.tid & 63; F.wave = __builtin_amdgcn_readfirstlane(F.tid >> 6);
    F.G = gridDim.x; { const int bx = blockIdx.x; F.vcu = (F.G % 8 == 0) ? (bx % 8) * (F.G / 8) + bx / 8 : bx; }
    unsigned char* ws = args.ws;
    F.ctl = (gu32*)(ws + WS_CTL);
    F.x = args.in[0]; F.w_in = args.in[1]; F.lq1 = args.in[2]; F.lk1 = args.in[3]; F.lq2 = args.in[4]; F.lk2 = args.in[5]; F.gsub = args.in[6]; F.relb = args.in[7];
    F.w_au = args.in[8]; F.w_dw = args.in[9]; F.b_dw = args.in[10]; F.g_cln = args.in[11]; F.b_cln = args.in[12]; F.w_pw = args.in[13]; F.b_pw = args.in[14]; F.w_out = args.in[15];
    F.g_mix = args.in[16]; F.g_ffn = args.in[17]; F.w_rg = args.in[18]; F.b_rg = args.in[19]; F.w_re = args.in[20]; F.b_re = args.in[21]; F.w_eg = args.in[22]; F.w_eu = args.in[23]; F.w_ed = args.in[24]; F.g_fin = args.in[25];
    F.out = args.out;
    F.Win_t = (bf16*)(ws + WS_WIN); F.Wmix_t = (bf16*)(ws + WS_WMIX); F.Wout_t = (bf16*)(ws + WS_WOUT); F.Wgu_t = (bf16*)(ws + WS_WGU); F.Wd_t = (bf16*)(ws + WS_WD);
    F.XN = (bf16*)(ws + WS_XN); F.Qb = (bf16*)(ws + WS_Q); F.Kb = (bf16*)(ws + WS_K); F.Vb = (bf16*)(ws + WS_V); F.U = (bf16*)(ws + WS_U); F.Gt = (bf16*)(ws + WS_G);
    F.AO = (bf16*)(ws + WS_AO); F.UC = (bf16*)(ws + WS_UC); F.MG = (bf16*)(ws + WS_MG); F.XG = (bf16*)(ws + WS_XG); F.ACT = (bf16*)(ws + WS_ACT); F.Y = (bf16*)(ws + WS_Y);
    F.T = (float*)(ws + WS_T); F.Wrf = (float*)(ws + WS_WRF); F.roww = (float*)(ws + WS_ROWW); F.tokinfo = (int*)(ws + WS_TOKINFO); F.tokslot = (int*)(ws + WS_TOKSLOT);
    for (int u = F.tid; u < 128; u += NWAVES * 64) ((LAS unsigned*)(F.lds + LDSCTL_OFF))[u] = 0u;
    __syncthreads();
    const int lo = args.ph_lo, hi = args.ph_hi;
    XcdBarrier bar; bar.bar = (unsigned*)(F.ctl + CW_BAR); bar.x = 0; bar.st = nullptr;
    if (hi - lo > 1) bar = xcd_barrier_post((unsigned*)(F.ctl + CW_BAR), (volatile LAS unsigned*)(F.lds + LDSCTL_OFF) + 8);
#ifndef PH_MASK
#define PH_MASK 0x3ff
#endif
#define IN(k) (((PH_MASK >> (k)) & 1) && lo <= (k) && (k) < hi)
#ifdef REP_BAR
#define SEAM(k) do { if (IN(k) && IN((k) + 1)) { xcd_barrier(bar); xcd_barrier(bar); } } while (0)
#else
#define SEAM(k) do { if (IN(k) && IN((k) + 1)) xcd_barrier(bar); } while (0)
#endif
    constexpr bool AL = true, SP = true;
#ifndef REP_MASK
#define REP_MASK 0
#endif
#define REPS(k) ((((REP_MASK) >> (k)) & 1) ? 2 : 1)

    if (IN(0)) { for (int rep = 0; rep < REPS(0); ++rep) { p0_prologue(F); if (rep + 1 < REPS(0)) __syncthreads(); } SEAM(0); }
    if (IN(1)) { for (int rep = 0; rep < REPS(1); ++rep) {
        pg8::Gemm g{F.XN, F.Win_t, M, NCOL, D}; pg8::StaticOrder S; S.init(M, NCOL, F.G, (int)blockIdx.x);
        EpiProj E{F.Qb, F.Kb, F.Vb, F.U, F.Gt};
        pg8::gemm_phase<EpiProj, pg8::StaticOrder, AL, SP>(F.lds + RING_OFF, g, S, E); }
        SEAM(1);
    }
#if defined(DBG_ZERO_P2)
    if (IN(2)) { for (size_t i = (size_t)blockIdx.x * 512 + F.tid; i < (size_t)M * 1024 * 2 / 16; i += (size_t)F.G * 512) ((GAS v4u*)F.AO)[i] = ((const GAS v4u*)F.XN)[i]; SEAM(2); }
#else
    if (IN(2)) { for (int rep = 0; rep < REPS(2); ++rep) p2_mixers(F); SEAM(2); }
#endif
    if (IN(3)) { for (int rep = 0; rep < REPS(3); ++rep) {
        pg8::Gemm g{F.AO, F.Wmix_t, 2 * M, 2048, 512}; PairOrder S; S.so.init(M, 1024, F.G, (int)blockIdx.x);
        EpiMerge E{F.Gt, F.b_pw, F.MG};
        pg8::gemm_phase<EpiMerge, PairOrder, AL, SP>(F.lds + RING_OFF, g, S, E); }
        SEAM(3);
    }
    if (IN(4)) { for (int rep = 0; rep < REPS(4); ++rep) {
        pg8::Gemm g{F.MG, F.Wout_t, M, D, D}; pg8::StaticOrder S; S.init(M, D, F.G, (int)blockIdx.x);
        EpiX1 E{F.x, F.out};
        pg8::gemm_phase<EpiX1, pg8::StaticOrder, AL, SP>(F.lds + RING_OFF, g, S, E); }
        SEAM(4);
    }
#ifdef REP_P5A
    if (IN(5)) { p5a_router(F, true); __syncthreads(); }
#endif
    if (IN(5)) { p5a_router(F, false); SEAM(5); }
    if (IN(6)) { for (int rep = 0; rep < REPS(6); ++rep) p5b_gather(F); SEAM(6); }
    if (IN(7)) { for (int rep = 0; rep < REPS(7); ++rep) {
        moe_tables(F);
        const LAS int* tab = (const LAS int*)(F.lds + MOE_TAB_OFF);
        pg8::Gemm g{F.XG, F.Wgu_t, MAXTILES * 256, NE * 1024, D}; MoeOrder S{tab + 129, tab[129 + MAXTILES], F.G, F.vcu};
        EpiSwiglu E{F.ACT};
        pg8::gemm_phase<EpiSwiglu, MoeOrder, AL, SP>(F.lds + RING_OFF, g, S, E); }
        SEAM(7);
    }
    if (IN(8)) { for (int rep = 0; rep < REPS(8); ++rep) {
        moe_tables(F);
        const LAS int* tab = (const LAS int*)(F.lds + MOE_TAB_OFF);
        pg8::Gemm g{F.ACT, F.Wd_t, MAXTILES * 256, NE * 1024, DE}; MoeOrder S{tab + 129, tab[129 + MAXTILES], F.G, F.vcu};
        EpiDown E{F.Y, F.roww};
        pg8::gemm_phase<EpiDown, MoeOrder, AL, SP>(F.lds + RING_OFF, g, S, E); }
        SEAM(8);
    }
#ifdef REP_P9
    if (IN(9)) { p8_final(F, (float*)F.XG); __syncthreads(); }
#endif
    if (IN(9)) { p8_final(F, F.out); }
#undef IN
#undef SEAM
}

#ifndef MK_N_LAUNCHES
#define MK_N_LAUNCHES 1
#endif
extern "C" void kernel_launch(void* const* d_in, const int* in_sizes, int n_in, void* d_out, int out_size, void* d_ws, size_t ws_size, hipStream_t stream) {
    static int grid = 0;
    if (grid == 0) {
        if (n_in != 26 || in_sizes[0] != M * D || out_size != M * D || ws_size < WS_END) { fprintf(stderr, "kernel_launch: unexpected shapes (n_in %d, in0 %d, out %d, ws %zu < %zu)\n", n_in, n_in > 0 ? in_sizes[0] : -1, out_size, ws_size, (size_t)WS_END); grid = -1; return; }
        int dev = 0, cus = 0, per_cu = 0;
        if (hipGetDevice(&dev) != hipSuccess || hipDeviceGetAttribute(&cus, hipDeviceAttributeMultiprocessorCount, dev) != hipSuccess) { grid = -1; return; }
        if (hipFuncSetAttribute((const void*)fwd_kernel, hipFuncAttributeMaxDynamicSharedMemorySize, LDS_BYTES) != hipSuccess) { fprintf(stderr, "kernel_launch: hipFuncSetAttribute failed\n"); grid = -1; return; }
        if (hipOccupancyMaxActiveBlocksPerMultiprocessor(&per_cu, (const void*)fwd_kernel, NWAVES * 64, LDS_BYTES) != hipSuccess || per_cu < 1)
            fprintf(stderr, "kernel_launch: occupancy query reports %d workgroups per CU\n", per_cu);
        (void)hipGetLastError();
        grid = cus;
    }
    if (grid < 0) return;
    if (hipMemsetAsync((char*)d_ws + WS_CTL, 0, CTL_ZERO_BYTES, stream) != hipSuccess) return;
    Args a{};
    for (int i = 0; i < 26; ++i) a.in[i] = (const float*)d_in[i];
    a.out = (float*)d_out; a.ws = (unsigned char*)d_ws;
#if MK_N_LAUNCHES == 1
    a.ph_lo = 0; a.ph_hi = NPHASE;
    hipLaunchKernelGGL(fwd_kernel, dim3(grid), dim3(NWAVES * 64), LDS_BYTES, stream, a);
#else
    for (int p = 0; p < NPHASE; ++p) { a.ph_lo = p; a.ph_hi = p + 1; hipLaunchKernelGGL(fwd_kernel, dim3(grid), dim3(NWAVES * 64), LDS_BYTES, stream, a); }
#endif
}
```

```cpp
#include <hip/hip_runtime.h>
#include <cstdio>
#include <cstdint>
#define MK_N_LAUNCHES 1
namespace pg8 {
#define PG8_LAS __attribute__((address_space(3)))
typedef unsigned short bf16_t;
typedef short bf16x8 __attribute__((ext_vector_type(8)));
typedef float f32x4 __attribute__((ext_vector_type(4)));
typedef unsigned u32x4 __attribute__((ext_vector_type(4)));
constexpr int BM = 256, BK = 64, HALF = 128, HTB = HALF * BK * 2  , STAGE_BYTES = 8 * HTB, NXCD = 8, WGM = 8;

__host__ __device__ __forceinline__ int lds_byte(int r, int c) { const int st = (r >> 4) * 2 + (c >> 5), rr = r & 15, cc = c & 31, ob = rr * 64 + cc * 2; return st * 1024 + (ob ^ (((ob >> 9) & 1) << 5)); }
__host__ __device__ __forceinline__ void stage_rc(int b, int& R, int& C) { const int st = b / 1024, sb = b % 1024, swz = sb ^ (((sb >> 9) & 1) << 5); R = (st >> 1) * 16 + swz / 64; C = (st & 1) * 32 + (swz % 64) / 2; }
__host__ __device__ __forceinline__ int perm32(int rho) { const int n = rho >> 4, i = rho & 15; return 8 * (i >> 2) + 4 * n + (i & 3); }

struct Unit { int pm, pn; };
struct Gemm { const bf16_t* A; const bf16_t* Bt; int M, N, K; };

struct StaticOrder {
    int nM, nN, nwg, G, c;
    __host__ __device__ void init(int M, int N, int G_, int c_) { nM = M / BM; nN = N / BM; nwg = nM * nN; G = G_; c = c_; }
    __host__ __device__ bool next(int i, Unit& u) const {
        const long L = (long)i * G + c; if (L >= nwg) return false;
        int wgid = (int)L; { const int q = nwg / NXCD, r = nwg % NXCD, xcd = wgid % NXCD, off = wgid / NXCD; wgid = (xcd < r ? xcd * (q + 1) : r * (q + 1) + (xcd - r) * q) + off; }
        const int nig = WGM * nN, gid = wgid / nig, fm = gid * WGM, gsz = (nM - fm) < WGM ? (nM - fm) : WGM;
        u.pm = fm + ((wgid % nig) % gsz); u.pn = (wgid % nig) / gsz; return true;
    }
    __device__ __forceinline__ void a_ready(const Unit&) const {}
    __device__ __forceinline__ void done(const Unit&) const {}
};

__device__ __forceinline__ unsigned cvt_pk_bf16(float lo, float hi) { unsigned r; asm volatile("v_cvt_pk_bf16_f32 %0, %1, %2" : "=v"(r) : "v"(lo), "v"(hi)); return r; }
typedef float f32x2 __attribute__((ext_vector_type(2)));
template <class Epi, class Sched, bool ALIGN_EPI = false, bool SP2 = false>
__device__ __forceinline__ void gemm_phase(PG8_LAS unsigned char* lds, const Gemm g, const Sched& S, const Epi& E) {
    const int tid = threadIdx.x, wid = __builtin_amdgcn_readfirstlane(tid >> 6), lane = tid & 63, wr = wid >> 2, wc = wid & 3, fr = lane & 15, fq = lane >> 4;
    const int K = g.K, nt = K / BK;
    unsigned voffA[2], voffB[2];
#pragma unroll
    for (int i = 0; i < 2; ++i) { int R, C; stage_rc(tid * 16 + i * 8192, R, C); const int Rb = Epi::PERM ? ((R & ~31) + perm32(R & 31)) : R;
        voffA[i] = (unsigned)(R * K + C) * 2u; voffB[i] = (unsigned)(Rb * K + C) * 2u; }
    const size_t kstep = (size_t)(BK * 2);
    const size_t hstep = (size_t)HALF * K * 2;
    const size_t tstep = 2 * hstep;
    const unsigned ldsw = (unsigned)wid * 1024u;
    const int aoff = lds_byte(wr * 64 + fr, fq * 8), boff = lds_byte(wc * 32 + fr, fq * 8);
#define PG8_SA(b, h) (((b) * 2 + (h)) * HTB)
#define PG8_SB(b, h) ((4 + (b) * 2 + (h)) * HTB)
#define PG8_STAGE(bufoff, gbase, voff) do { _Pragma("unroll") for (int _i = 0; _i < 2; ++_i) \
        __builtin_amdgcn_global_load_lds((const unsigned*)((const char*)(gbase) + (voff)[_i]), (PG8_LAS unsigned*)(lds + (bufoff) + ldsw + _i * 8192), 16, 0, 0); } while (0)
#define PG8_LDA(dst, b, h) do { _Pragma("unroll") for (int m = 0; m < 4; ++m) _Pragma("unroll") for (int k = 0; k < 2; ++k) dst[m][k] = *(const PG8_LAS bf16x8*)(lds + PG8_SA(b, h) + aoff + m * 2048 + k * 1024); } while (0)
#define PG8_LDB(dst, b, h) do { _Pragma("unroll") for (int n = 0; n < 2; ++n) _Pragma("unroll") for (int k = 0; k < 2; ++k) dst[n][k] = *(const PG8_LAS bf16x8*)(lds + PG8_SB(b, h) + boff + n * 2048 + k * 1024); } while (0)
#define PG8_MMA(ai, bj, At, Bt) do { __builtin_amdgcn_s_setprio(1); _Pragma("unroll") for (int m = 0; m < 4; ++m) _Pragma("unroll") for (int n = 0; n < 2; ++n) _Pragma("unroll") for (int k = 0; k < 2; ++k) \
        acc[ai][bj][m][n] = __builtin_amdgcn_mfma_f32_16x16x32_bf16(Bt[n][k], At[m][k], acc[ai][bj][m][n], 0, 0, 0); __builtin_amdgcn_s_setprio(0); } while (0)
#define PG8_WAIT_V(n) asm volatile("s_waitcnt vmcnt(" #n ")" ::: "memory")
#define PG8_WAIT_L(n) asm volatile("s_waitcnt lgkmcnt(" #n ")" ::: "memory")
#define PG8_BAR __builtin_amdgcn_s_barrier()
#define PG8_SCHED __builtin_amdgcn_sched_barrier(0)
    Unit cur, nxt; int ui = 0;
    if (!S.next(0, cur)) return;
    f32x4 acc[2][2][4][2];
#pragma unroll
    for (int a = 0; a < 2; ++a)
#pragma unroll
        for (int b = 0; b < 2; ++b)
#pragma unroll
            for (int m = 0; m < 4; ++m)
#pragma unroll
                for (int n = 0; n < 2; ++n) acc[a][b][m][n] = (f32x4){0.f, 0.f, 0.f, 0.f};
    bf16x8 At[4][2], B0[2][2], B1[2][2];
    const char* cA = (const char*)g.A + (size_t)cur.pm * tstep; const char* cB = (const char*)g.Bt + (size_t)cur.pn * tstep;
    S.a_ready(cur);
    if constexpr (SP2) {
        PG8_STAGE(PG8_SB(0, 0), cB, voffB); PG8_STAGE(PG8_SB(0, 1), cB + hstep, voffB); PG8_STAGE(PG8_SA(0, 0), cA, voffA); PG8_STAGE(PG8_SA(0, 1), cA + hstep, voffA);
        if (wr == 1) PG8_BAR;
        PG8_WAIT_V(2); PG8_BAR;
        PG8_STAGE(PG8_SB(1, 0), cB + kstep, voffB); PG8_STAGE(PG8_SA(1, 0), cA + kstep, voffA); PG8_STAGE(PG8_SB(1, 1), cB + hstep + kstep, voffB);
        PG8_WAIT_V(6); PG8_BAR;
    } else {
        PG8_STAGE(PG8_SB(0, 0), cB, voffB); PG8_STAGE(PG8_SA(0, 0), cA, voffA); PG8_STAGE(PG8_SB(0, 1), cB + hstep, voffB); PG8_STAGE(PG8_SA(0, 1), cA + hstep, voffA);
        if (wr == 1) PG8_BAR;
        PG8_WAIT_V(4); PG8_BAR;
        PG8_STAGE(PG8_SB(1, 0), cB + kstep, voffB); PG8_STAGE(PG8_SA(1, 0), cA + kstep, voffA); PG8_STAGE(PG8_SB(1, 1), cB + hstep + kstep, voffB);
        PG8_WAIT_V(6); PG8_BAR;
    }
    for (;;) {
        const bool has_next = S.next(ui + 1, nxt);
        const char* nA = has_next ? (const char*)g.A + (size_t)nxt.pm * tstep : cA; const char* nB = has_next ? (const char*)g.Bt + (size_t)nxt.pn * tstep : cB;
        for (int t = 0; t < nt; t += 2) {
            const bool last = (t == nt - 2);
            const char* a1 = cA + (size_t)(t + 1) * kstep;
            const char* a2 = last ? nA : cA + (size_t)(t + 2) * kstep; const char* b2 = last ? nB : cB + (size_t)(t + 2) * kstep;
            const char* a3 = a2 + kstep; const char* b3 = b2 + kstep;
            if (last && has_next) S.a_ready(nxt);
            if constexpr (SP2) {
            PG8_LDB(B0, 0, 0); PG8_LDB(B1, 0, 1); PG8_SCHED; PG8_LDA(At, 0, 0); PG8_STAGE(PG8_SA(1, 1), a1 + hstep, voffA);
            PG8_WAIT_V(8); PG8_WAIT_L(0); PG8_BAR; PG8_MMA(0, 0, At, B0); PG8_MMA(0, 1, At, B1); PG8_BAR; PG8_SCHED;
            PG8_LDA(At, 0, 1); PG8_STAGE(PG8_SB(0, 0), b2, voffB); PG8_STAGE(PG8_SB(0, 1), b2 + hstep, voffB); PG8_STAGE(PG8_SA(0, 0), a2, voffA);
            PG8_WAIT_V(8); PG8_WAIT_L(0); PG8_BAR; PG8_MMA(1, 0, At, B0); PG8_MMA(1, 1, At, B1); PG8_BAR; PG8_SCHED;
            PG8_LDB(B0, 1, 0); PG8_LDB(B1, 1, 1); PG8_SCHED; PG8_LDA(At, 1, 0); PG8_STAGE(PG8_SA(0, 1), a2 + hstep, voffA);
            PG8_WAIT_V(8); PG8_WAIT_L(0); PG8_BAR; PG8_MMA(0, 0, At, B0); PG8_MMA(0, 1, At, B1); PG8_BAR; PG8_SCHED;
            PG8_LDA(At, 1, 1); PG8_STAGE(PG8_SB(1, 0), b3, voffB); PG8_STAGE(PG8_SB(1, 1), b3 + hstep, voffB); PG8_STAGE(PG8_SA(1, 0), a3, voffA);
            PG8_WAIT_V(8); PG8_WAIT_L(0); PG8_BAR; PG8_MMA(1, 0, At, B0); PG8_MMA(1, 1, At, B1); PG8_BAR; PG8_SCHED;
            } else {
            PG8_LDB(B0, 0, 0); PG8_SCHED; PG8_LDA(At, 0, 0); PG8_STAGE(PG8_SA(1, 1), a1 + hstep, voffA);
            PG8_WAIT_L(8); PG8_BAR; PG8_WAIT_L(0); PG8_MMA(0, 0, At, B0); PG8_BAR; PG8_SCHED;
            PG8_LDB(B1, 0, 1); PG8_STAGE(PG8_SB(0, 0), b2, voffB);
            PG8_BAR; PG8_WAIT_L(0); PG8_MMA(0, 1, At, B1); PG8_BAR;
            PG8_LDA(At, 0, 1); PG8_STAGE(PG8_SA(0, 0), a2, voffA);
            PG8_BAR; PG8_WAIT_L(0); PG8_MMA(1, 0, At, B0); PG8_BAR; PG8_SCHED;
            PG8_STAGE(PG8_SB(0, 1), b2 + hstep, voffB);
            PG8_WAIT_V(6); PG8_BAR; PG8_MMA(1, 1, At, B1); PG8_BAR;
            PG8_LDB(B0, 1, 0); PG8_SCHED; PG8_LDA(At, 1, 0); PG8_STAGE(PG8_SA(0, 1), a2 + hstep, voffA);
            PG8_WAIT_L(8); PG8_BAR; PG8_WAIT_L(0); PG8_MMA(0, 0, At, B0); PG8_BAR; PG8_SCHED;
            PG8_LDB(B1, 1, 1); PG8_STAGE(PG8_SB(1, 0), b3, voffB);
            PG8_BAR; PG8_WAIT_L(0); PG8_MMA(0, 1, At, B1); PG8_BAR;
            PG8_LDA(At, 1, 1); PG8_STAGE(PG8_SA(1, 0), a3, voffA);
            PG8_BAR; PG8_WAIT_L(0); PG8_MMA(1, 0, At, B0); PG8_BAR; PG8_SCHED;
            PG8_STAGE(PG8_SB(1, 1), b3 + hstep, voffB);
            PG8_WAIT_V(6); PG8_BAR; PG8_MMA(1, 1, At, B1); PG8_BAR;
            }
        }
        if constexpr (ALIGN_EPI) { if (wr == 0) PG8_BAR; }
        if constexpr (!Epi::AFTER_DRAIN) { E(acc, cur, wr, wc, fr, fq); S.done(cur); }
        if (!has_next) break;
#pragma unroll
        for (int a = 0; a < 2; ++a)
#pragma unroll
            for (int b = 0; b < 2; ++b)
#pragma unroll
                for (int m = 0; m < 4; ++m)
#pragma unroll
                    for (int n = 0; n < 2; ++n) acc[a][b][m][n] = (f32x4){0.f, 0.f, 0.f, 0.f};
        cur = nxt; cA = nA; cB = nB; ++ui;
        if constexpr (ALIGN_EPI) { if (wr == 1) PG8_BAR; }
    }
    PG8_WAIT_V(0);
    if constexpr (!ALIGN_EPI) { if (wr == 0) PG8_BAR; }
    PG8_BAR;
    if constexpr (Epi::AFTER_DRAIN) { E.fused(acc, cur, wr, wc, fr, fq, lds, wid, lane); S.done(cur); }
#undef PG8_SA
#undef PG8_SB
#undef PG8_STAGE
#undef PG8_LDA
#undef PG8_LDB
#undef PG8_MMA
#undef PG8_WAIT_V
#undef PG8_WAIT_L
#undef PG8_BAR
#undef PG8_SCHED
}
}
namespace pg8 {
template <class Epi, class Sched, bool ALIGN_EPI = false>
__device__ __forceinline__ void gemm_phase_g(PG8_LAS unsigned char* lds, const Gemm g, const PG8_LAS int* rowtab  , const Sched& S, const Epi& E) {
    constexpr bool SP2 = true;
    const int tid = threadIdx.x, wid = __builtin_amdgcn_readfirstlane(tid >> 6), lane = tid & 63, wr = wid >> 2, wc = wid & 3, fr = lane & 15, fq = lane >> 4;
    const int K = g.K, nt = K / BK;
    unsigned voffA[2], voffB[2], CA2[2]; int RA[2];
#pragma unroll
    for (int i = 0; i < 2; ++i) { int R, C; stage_rc(tid * 16 + i * 8192, R, C); const int Rb = Epi::PERM ? ((R & ~31) + perm32(R & 31)) : R;
        voffA[i] = (unsigned)(R * K + C) * 2u; voffB[i] = (unsigned)(Rb * K + C) * 2u; RA[i] = R; CA2[i] = (unsigned)C * 2u; }
    const size_t kstep = (size_t)(BK * 2);
    const size_t hstep = (size_t)HALF * K * 2;
    const size_t tstep = 2 * hstep;
    const unsigned ldsw = (unsigned)wid * 1024u;
    const int aoff = lds_byte(wr * 64 + fr, fq * 8), boff = lds_byte(wc * 32 + fr, fq * 8);
#define PG8_SA(b, h) (((b) * 2 + (h)) * HTB)
#define PG8_SB(b, h) ((4 + (b) * 2 + (h)) * HTB)
#define PG8_STAGE(bufoff, gbase, voff) do { _Pragma("unroll") for (int _i = 0; _i < 2; ++_i) \
        __builtin_amdgcn_global_load_lds((const unsigned*)((const char*)(gbase) + (voff)[_i]), (PG8_LAS unsigned*)(lds + (bufoff) + ldsw + _i * 8192), 16, 0, 0); } while (0)
#define PG8_STAGE_A(bufoff, offs, koff) do { _Pragma("unroll") for (int _i = 0; _i < 2; ++_i) \
        __builtin_amdgcn_global_load_lds((const unsigned*)((const char*)g.A + (size_t)(offs)[_i] + (size_t)(koff)), (PG8_LAS unsigned*)(lds + (bufoff) + ldsw + _i * 8192), 16, 0, 0); } while (0)
#define PG8_ROWS(dst, pm_) do { _Pragma("unroll") for (int _h = 0; _h < 2; ++_h) _Pragma("unroll") for (int _i = 0; _i < 2; ++_i) \
        dst[_h][_i] = (unsigned)rowtab[(pm_) * BM + _h * HALF + RA[_i]] * (unsigned)(K * 2) + CA2[_i]; } while (0)
#define PG8_LDA(dst, b, h) do { _Pragma("unroll") for (int m = 0; m < 4; ++m) _Pragma("unroll") for (int k = 0; k < 2; ++k) dst[m][k] = *(const PG8_LAS bf16x8*)(lds + PG8_SA(b, h) + aoff + m * 2048 + k * 1024); } while (0)
#define PG8_LDB(dst, b, h) do { _Pragma("unroll") for (int n = 0; n < 2; ++n) _Pragma("unroll") for (int k = 0; k < 2; ++k) dst[n][k] = *(const PG8_LAS bf16x8*)(lds + PG8_SB(b, h) + boff + n * 2048 + k * 1024); } while (0)
#define PG8_MMA(ai, bj, At, Bt) do { __builtin_amdgcn_s_setprio(1); _Pragma("unroll") for (int m = 0; m < 4; ++m) _Pragma("unroll") for (int n = 0; n < 2; ++n) _Pragma("unroll") for (int k = 0; k < 2; ++k) \
        acc[ai][bj][m][n] = __builtin_amdgcn_mfma_f32_16x16x32_bf16(Bt[n][k], At[m][k], acc[ai][bj][m][n], 0, 0, 0); __builtin_amdgcn_s_setprio(0); } while (0)
#define PG8_WAIT_V(n) asm volatile("s_waitcnt vmcnt(" #n ")" ::: "memory")
#define PG8_WAIT_L(n) asm volatile("s_waitcnt lgkmcnt(" #n ")" ::: "memory")
#define PG8_BAR __builtin_amdgcn_s_barrier()
#define PG8_SCHED __builtin_amdgcn_sched_barrier(0)
    Unit cur, nxt; int ui = 0;
    if (!S.next(0, cur)) return;
    f32x4 acc[2][2][4][2];
#pragma unroll
    for (int a = 0; a < 2; ++a)
#pragma unroll
        for (int b = 0; b < 2; ++b)
#pragma unroll
            for (int m = 0; m < 4; ++m)
#pragma unroll
                for (int n = 0; n < 2; ++n) acc[a][b][m][n] = (f32x4){0.f, 0.f, 0.f, 0.f};
    bf16x8 At[4][2], B0[2][2], B1[2][2];
    const char* cB = (const char*)g.Bt + (size_t)cur.pn * tstep;
    unsigned ao[2][2], an[2][2]; PG8_ROWS(ao, 0);
    S.a_ready(cur);
    if constexpr (SP2) {
        PG8_STAGE(PG8_SB(0, 0), cB, voffB); PG8_STAGE(PG8_SB(0, 1), cB + hstep, voffB); PG8_STAGE_A(PG8_SA(0, 0), ao[0], 0); PG8_STAGE_A(PG8_SA(0, 1), ao[1], 0);
        if (wr == 1) PG8_BAR;
        PG8_WAIT_V(2); PG8_BAR;
        PG8_STAGE(PG8_SB(1, 0), cB + kstep, voffB); PG8_STAGE_A(PG8_SA(1, 0), ao[0], kstep); PG8_STAGE(PG8_SB(1, 1), cB + hstep + kstep, voffB);
        PG8_WAIT_V(6); PG8_BAR;
    }
    for (;;) {
        const bool has_next = S.next(ui + 1, nxt);
        const char* nB = has_next ? (const char*)g.Bt + (size_t)nxt.pn * tstep : cB;
        if (has_next) PG8_ROWS(an, ui + 1); else { an[0][0] = ao[0][0]; an[0][1] = ao[0][1]; an[1][0] = ao[1][0]; an[1][1] = ao[1][1]; }
        for (int t = 0; t < nt; t += 2) {
            const bool last = (t == nt - 2);
            const char* b2 = last ? nB : cB + (size_t)(t + 2) * kstep; const char* b3 = b2 + kstep;
            unsigned s2[2][2]; s2[0][0] = last ? an[0][0] : ao[0][0]; s2[0][1] = last ? an[0][1] : ao[0][1]; s2[1][0] = last ? an[1][0] : ao[1][0]; s2[1][1] = last ? an[1][1] : ao[1][1];
            const size_t k1 = (size_t)(t + 1) * kstep, k2 = last ? 0 : (size_t)(t + 2) * kstep, k3 = k2 + kstep;
            if (last && has_next) S.a_ready(nxt);
            if constexpr (SP2) {
            PG8_LDB(B0, 0, 0); PG8_LDB(B1, 0, 1); PG8_SCHED; PG8_LDA(At, 0, 0); PG8_STAGE_A(PG8_SA(1, 1), ao[1], k1);
            PG8_WAIT_V(8); PG8_WAIT_L(0); PG8_BAR; PG8_MMA(0, 0, At, B0); PG8_MMA(0, 1, At, B1); PG8_BAR; PG8_SCHED;
            PG8_LDA(At, 0, 1); PG8_STAGE(PG8_SB(0, 0), b2, voffB); PG8_STAGE(PG8_SB(0, 1), b2 + hstep, voffB); PG8_STAGE_A(PG8_SA(0, 0), s2[0], k2);
            PG8_WAIT_V(8); PG8_WAIT_L(0); PG8_BAR; PG8_MMA(1, 0, At, B0); PG8_MMA(1, 1, At, B1); PG8_BAR; PG8_SCHED;
            PG8_LDB(B0, 1, 0); PG8_LDB(B1, 1, 1); PG8_SCHED; PG8_LDA(At, 1, 0); PG8_STAGE_A(PG8_SA(0, 1), s2[1], k2);
            PG8_WAIT_V(8); PG8_WAIT_L(0); PG8_BAR; PG8_MMA(0, 0, At, B0); PG8_MMA(0, 1, At, B1); PG8_BAR; PG8_SCHED;
            PG8_LDA(At, 1, 1); PG8_STAGE(PG8_SB(1, 0), b3, voffB); PG8_STAGE(PG8_SB(1, 1), b3 + hstep, voffB); PG8_STAGE_A(PG8_SA(1, 0), s2[0], k3);
            PG8_WAIT_V(8); PG8_WAIT_L(0); PG8_BAR; PG8_MMA(1, 0, At, B0); PG8_MMA(1, 1, At, B1); PG8_BAR; PG8_SCHED;
            }
        }
        if constexpr (ALIGN_EPI) { if (wr == 0) PG8_BAR; }
        if constexpr (!Epi::AFTER_DRAIN) { E(acc, cur, wr, wc, fr, fq); S.done(cur); }
        if (!has_next) break;
#pragma unroll
        for (int a = 0; a < 2; ++a)
#pragma unroll
            for (int b = 0; b < 2; ++b)
#pragma unroll
                for (int m = 0; m < 4; ++m)
#pragma unroll
                    for (int n = 0; n < 2; ++n) acc[a][b][m][n] = (f32x4){0.f, 0.f, 0.f, 0.f};
        cur = nxt; cB = nB; ++ui; ao[0][0] = an[0][0]; ao[0][1] = an[0][1]; ao[1][0] = an[1][0]; ao[1][1] = an[1][1];
        if constexpr (ALIGN_EPI) { if (wr == 1) PG8_BAR; }
    }
    PG8_WAIT_V(0);
    if constexpr (!ALIGN_EPI) { if (wr == 0) PG8_BAR; }
    PG8_BAR;
    if constexpr (Epi::AFTER_DRAIN) { E.fused(acc, cur, wr, wc, fr, fq, lds, wid, lane); S.done(cur); }
#undef PG8_SA
#undef PG8_SB
#undef PG8_STAGE
#undef PG8_STAGE_A
#undef PG8_ROWS
#undef PG8_LDA
#undef PG8_LDB
#undef PG8_MMA
#undef PG8_WAIT_V
#undef PG8_WAIT_L
#undef PG8_BAR
#undef PG8_SCHED
}
}
constexpr int NWAVES = 8;
constexpr int NB = 4, SEQ = 4096, D = 1024, M = NB * SEQ;
constexpr int NH = 4, VD = 128, AW = 512, CWID = 512, CK = 31;
constexpr int NCOL = 4608;
constexpr int NE = 64, DE = 512;
constexpr float EPS = 1e-6f;
constexpr float LOG2E = 1.4426950408889634f;
constexpr float QSCALE = 0.125f * LOG2E;
constexpr int MAXTILES = 192;
constexpr int NPHASE = 10;

constexpr size_t MiB = 1u << 20;
constexpr size_t WS_CTL = 0, CTL_ZERO_BYTES = 1 * MiB;
constexpr size_t WS_WRF = 1 * MiB;
constexpr size_t WS_TOKINFO = 2 * MiB;
constexpr size_t WS_TOKSLOT = 2 * MiB + 512 * 1024;
constexpr size_t WS_ROWW = 2 * MiB + 768 * 1024;
constexpr size_t WS_WIN = 4 * MiB;
constexpr size_t WS_WMIX = 13 * MiB;
constexpr size_t WS_WOUT = 15 * MiB;
constexpr size_t WS_WGU = 17 * MiB;
constexpr size_t WS_WD = 145 * MiB;
constexpr size_t WS_B = 209 * MiB;
constexpr size_t WS_XN = WS_B + 0 * MiB;
constexpr size_t WS_Q = WS_B + 32 * MiB;
constexpr size_t WS_K = WS_B + 48 * MiB;
constexpr size_t WS_V = WS_B + 64 * MiB;
constexpr size_t WS_U = WS_B + 80 * MiB;
constexpr size_t WS_G = WS_B + 96 * MiB;
constexpr size_t WS_AO = WS_B + 160 * MiB;
constexpr size_t WS_UC = WS_B + 176 * MiB;
constexpr size_t WS_MG = WS_B + 192 * MiB;
constexpr size_t WS_T = WS_B + 0 * MiB;
constexpr size_t WS_XH = WS_B + 0 * MiB;
constexpr size_t WS_ACT = WS_B + 96 * MiB;
constexpr size_t WS_Y = WS_B + 144 * MiB;
constexpr size_t WS_END = WS_B + 240 * MiB;
constexpr int CW_BAR = 4096;
constexpr int CW_GCNT = 8192;
constexpr int CW_NTILE = 12288;
constexpr int CW_TEXP = 12352;
constexpr int CW_TMAP = 16384;
constexpr int CW_ROWTOK = 65536;

constexpr int RING_OFF = 0, RING_BYTES = 131072;
constexpr int LDSCTL_OFF = 155648;
constexpr int ATT_TAB_OFF = LDSCTL_OFF + 512;
constexpr int MOE_TAB_OFF = LDSCTL_OFF + 4096;
constexpr int LDS_BYTES = 163840;

#define GAS __attribute__((address_space(1)))
#define LAS __attribute__((address_space(3)))
typedef unsigned short bf16;
typedef unsigned v4u __attribute__((ext_vector_type(4)));
typedef unsigned v2u __attribute__((ext_vector_type(2)));
typedef float f32x4 __attribute__((ext_vector_type(4)));
typedef float f32x16 __attribute__((ext_vector_type(16)));
typedef short bf16x8 __attribute__((ext_vector_type(8)));
typedef short s16x4 __attribute__((ext_vector_type(4)));
typedef GAS unsigned gu32;
#define RLX_AGENT __ATOMIC_RELAXED, __HIP_MEMORY_SCOPE_AGENT
#define LDS_WAIT() asm volatile("s_waitcnt lgkmcnt(0)" ::: "memory")
#define VM_WAIT() asm volatile("s_waitcnt vmcnt(0)" ::: "memory")
typedef float f32x2_t __attribute__((ext_vector_type(2)));
typedef __bf16 bf16x2_t __attribute__((ext_vector_type(2)));
__device__ __forceinline__ unsigned pk2(float lo, float hi) { f32x2_t v = {lo, hi}; bf16x2_t b = __builtin_convertvector(v, bf16x2_t); return __builtin_bit_cast(unsigned, b); }
__device__ __forceinline__ float bf2f(unsigned short h) { return __uint_as_float((unsigned)h << 16); }
__device__ __forceinline__ float bflo(unsigned w) { return __uint_as_float(w << 16); }
__device__ __forceinline__ float bfhi(unsigned w) { return __uint_as_float(w & 0xffff0000u); }
__device__ __forceinline__ float sigmoidf_(float x) { return __builtin_amdgcn_rcpf(1.f + __expf(-x)); }
__device__ __forceinline__ float wave_sum(float v) {
#pragma unroll
    for (int o = 1; o < 64; o <<= 1) v += __shfl_xor(v, o);
    return v;
}
__device__ __forceinline__ float xhalf_max(float a) { auto rr = __builtin_amdgcn_permlane32_swap(__float_as_uint(a), __float_as_uint(a), false, false); return fmaxf(__uint_as_float(rr[0]), __uint_as_float(rr[1])); }
__device__ __forceinline__ float xhalf_sum(float a) { auto rr = __builtin_amdgcn_permlane32_swap(__float_as_uint(a), __float_as_uint(a), false, false); return __uint_as_float(rr[0]) + __uint_as_float(rr[1]); }
__device__ __forceinline__ int crow(int r, int hi) { return (r & 3) + 8 * (r >> 2) + 4 * hi; }

#define XB_TMO      128
#define XB_XCNT(j)  (256  + 64 * (j))
#define XB_XSUB(j)  (1280 + 64 * (j))
#define XB_XGEN(j)  (2304 + 64 * (j))
#define XB_TOP      3328
#define XB_TOPGEN   3392
#define XCD_BAR_WORDS 3456
#define XB_SPIN_CAP (1u << 18)

__device__ __forceinline__ unsigned xb_ld(unsigned* p)              { return __hip_atomic_load(p, __ATOMIC_RELAXED, __HIP_MEMORY_SCOPE_AGENT); }
__device__ __forceinline__ unsigned xb_add(unsigned* p, unsigned v) { return __hip_atomic_fetch_add(p, v, __ATOMIC_RELAXED, __HIP_MEMORY_SCOPE_AGENT); }
__device__ __forceinline__ unsigned xb_xcc_id() { return (unsigned)__builtin_amdgcn_s_getreg((3 << 11) | 20) & 0xFu; }
#define XB_SPIN(cond, bar) do { unsigned _sp = 0; while (cond) { __builtin_amdgcn_s_sleep(1); \
    if ((++_sp & 255u) == 0u) { if (xb_ld(&(bar)[XB_TMO])) break; if (_sp > XB_SPIN_CAP) { atomicAdd(&(bar)[XB_TMO], 1u); break; } } } } while (0)

struct XcdBarrier {
    unsigned* bar; unsigned x;
    volatile LAS unsigned* st;
};

__device__ __forceinline__ XcdBarrier xcd_barrier_post(unsigned* bar, volatile LAS unsigned* st) {
    XcdBarrier b; b.bar = bar; b.x = xb_xcc_id(); b.st = st;
    if (threadIdx.x == 0) (void)xb_add(&bar[XB_XCNT(b.x)], 1u);
    return b;
}
__device__ __forceinline__ void xcd_barrier_complete(unsigned* bar, unsigned x, unsigned& nloc, unsigned& nx) {
    const unsigned G = gridDim.x * gridDim.y * gridDim.z;
    unsigned sum, cnt, mine, sp = 0u;
    for (;;) {
        sum = 0u; cnt = 0u; mine = 0u;
#pragma unroll
        for (unsigned j = 0; j < 16; ++j) { const unsigned c = xb_ld(&bar[XB_XCNT(j)]); sum += c; cnt += (c > 0u) ? 1u : 0u; mine = (j == x) ? c : mine; }
        if (sum == G) break;
        __builtin_amdgcn_s_sleep(1);
        if ((++sp & 255u) == 0u) { if (xb_ld(&bar[XB_TMO])) break; if (sp > XB_SPIN_CAP) { atomicAdd(&bar[XB_TMO], 1u); break; } }
    }
    nloc = mine > 0u ? mine : 1u; nx = cnt > 0u ? cnt : 1u;
}

__device__ __forceinline__ void xcd_barrier(const XcdBarrier& b) {
    asm volatile("s_waitcnt vmcnt(0)" ::: "memory");
    __syncthreads();
    if (threadIdx.x == 0) {
        unsigned* bar = b.bar;
        __builtin_amdgcn_s_waitcnt(0);
        unsigned nloc = b.st[0], nx = b.st[1];
        if (nloc == 0u) { xcd_barrier_complete(bar, b.x, nloc, nx); b.st[0] = nloc; b.st[1] = nx; }
        const unsigned old = xb_add(&bar[XB_XSUB(b.x)], 1u);
        const unsigned gen = old / nloc;
        if (old + 1u == (gen + 1u) * nloc) {
            __builtin_amdgcn_fence(__ATOMIC_RELEASE, "agent");
            asm volatile("s_waitcnt vmcnt(0)" ::: "memory");
            const unsigned og = xb_add(&bar[XB_TOP], 1u);
            const unsigned tg = og / nx;
            if (og + 1u == (tg + 1u) * nx) xb_add(&bar[XB_TOPGEN], 1u);
            else XB_SPIN(xb_ld(&bar[XB_TOPGEN]) == tg, bar);
            __builtin_amdgcn_fence(__ATOMIC_ACQUIRE, "agent");
            xb_add(&bar[XB_XGEN(b.x)], 1u);
            asm volatile("s_waitcnt vmcnt(0)" ::: "memory");
        } else {
            XB_SPIN(xb_ld(&bar[XB_XGEN(b.x)]) == gen, bar);
            __builtin_amdgcn_fence(__ATOMIC_ACQUIRE, "agent");
            asm volatile("s_waitcnt vmcnt(0)" ::: "memory");
        }
    }
    __syncthreads();
}
#ifndef XP_IN_ATTN
#define XP_IN_ATTN 1
#endif

struct Frame {
    LAS unsigned char* lds;
    gu32* ctl;
    int tid, lane, wave;
    int vcu, G;
    const float *x, *w_in, *lq1, *lk1, *lq2, *lk2, *gsub, *relb, *w_au, *w_dw, *b_dw, *g_cln, *b_cln, *w_pw, *b_pw, *w_out, *g_mix, *g_ffn,
                *w_rg, *b_rg, *w_re, *b_re, *w_eg, *w_eu, *w_ed, *g_fin;
    float* out;
    bf16 *Win_t, *Wmix_t, *Wout_t, *Wgu_t, *Wd_t;
    bf16 *XN, *Qb, *Kb, *Vb, *U, *Gt, *AO, *UC, *MG, *XH, *ACT, *Y;
    float *T, *Wrf, *roww;
    int *tokinfo, *tokslot;
};

__device__ __forceinline__ int win_src_col(int pc) {
    if (pc < 1536 || pc >= 2560) return pc;
    const int t = (pc - 1536) >> 8, w = (pc - 1536) & 255, bj = w >> 7, i = w & 127;
    return 1536 + bj * 512 + t * 128 + i;
}
__device__ __forceinline__ void tr_tile(const float* src, int ldn, int k0, int c0, bf16* dst, int K, size_t r0, LAS unsigned* scr, int lane) {
    const int n4 = (lane & 15) * 4, kr = lane >> 4;
    f32x4 a[8], b[8];
#pragma unroll
    for (int i = 0; i < 8; ++i) { const int kp = 4 * i + kr;
        a[i] = *(const GAS f32x4*)(src + (size_t)(k0 + 2 * kp) * ldn + c0 + n4);
        b[i] = *(const GAS f32x4*)(src + (size_t)(k0 + 2 * kp + 1) * ldn + c0 + n4); }
#pragma unroll
    for (int i = 0; i < 8; ++i) { const int kp = 4 * i + kr;
        scr[(n4 + 0) * 33 + kp] = pk2(a[i].x, b[i].x); scr[(n4 + 1) * 33 + kp] = pk2(a[i].y, b[i].y);
        scr[(n4 + 2) * 33 + kp] = pk2(a[i].z, b[i].z); scr[(n4 + 3) * 33 + kp] = pk2(a[i].w, b[i].w); }
    LDS_WAIT(); asm volatile("" ::: "memory");
#pragma unroll
    for (int jj = 0; jj < 8; ++jj) { const int n = (lane >> 3) + 8 * jj, ch = lane & 7;
        v4u o; o.x = scr[n * 33 + ch * 4 + 0]; o.y = scr[n * 33 + ch * 4 + 1]; o.z = scr[n * 33 + ch * 4 + 2]; o.w = scr[n * 33 + ch * 4 + 3];
        *(GAS v4u*)(dst + (r0 + n) * (size_t)K + k0 + ch * 8) = o; }
    LDS_WAIT(); asm volatile("" ::: "memory");
}
__device__ __forceinline__ void p0_prologue(Frame& F) {
    LAS unsigned* scr = (LAS unsigned*)(F.lds + RING_OFF + F.wave * 8704);
    const int gw = F.vcu * NWAVES + F.wave, NGW = F.G * NWAVES, lane = F.lane;
    constexpr int I_IN = 16 * 72, I_AU = 8 * 16, I_PW = 8 * 16, I_OUT = 16 * 16, I_EXP = 384;
    constexpr int NITEMS = I_IN + I_AU + I_PW + I_OUT + (XP_IN_ATTN ? 0 : NE * I_EXP);
    for (int it = gw; it < NITEMS; it += NGW) {
        int r = it;
        if (r < I_IN) { const int kt = r / 72, rt = r % 72; tr_tile(F.w_in, NCOL, kt * 64, win_src_col(rt * 64), F.Win_t, 1024, (size_t)rt * 64, scr, lane); continue; } r -= I_IN;
        if (r < I_AU) { const int kt = r / 16, rt = r % 16; tr_tile(F.w_au, 1024, kt * 64, rt * 64, F.Wmix_t, 512, (size_t)rt * 64, scr, lane); continue; } r -= I_AU;
        if (r < I_PW) { const int kt = r / 16, rt = r % 16; tr_tile(F.w_pw, 1024, kt * 64, rt * 64, F.Wmix_t, 512, (size_t)1024 + rt * 64, scr, lane); continue; } r -= I_PW;
        if (r < I_OUT) { const int kt = r / 16, rt = r % 16; tr_tile(F.w_out, 1024, kt * 64, rt * 64, F.Wout_t, 1024, (size_t)rt * 64, scr, lane); continue; } r -= I_OUT;
        const int e = r / I_EXP; r -= e * I_EXP;
        if (r < 256) {
            const int bj = r >> 7, q = r & 127, kt = q >> 3, ct = q & 7, c0 = ct * 64;
            const float* src = (bj ? F.w_eu : F.w_eg) + (size_t)e * 1024 * 512;
            tr_tile(src, 512, kt * 64, c0, F.Wgu_t, 1024, (size_t)e * 1024 + (c0 >> 7) * 256 + bj * 128 + (c0 & 127), scr, lane);
        } else {
            const int q = r - 256, kt = q >> 4, ct = q & 15;
            tr_tile(F.w_ed + (size_t)e * 512 * 1024, 1024, kt * 64, ct * 64, F.Wd_t, 512, (size_t)e * 1024 + ct * 64, scr, lane);
        }
    }
    for (int m = gw; m < M; m += NGW) {
        const GAS f32x4* xr = (const GAS f32x4*)(F.x + (size_t)m * D) + lane; const GAS f32x4* gr = (const GAS f32x4*)F.g_mix + lane;
        f32x4 v[4]; float s = 0.f;
#pragma unroll
        for (int j = 0; j < 4; ++j) { v[j] = xr[64 * j]; s += (v[j].x * v[j].x + v[j].y * v[j].y) + (v[j].z * v[j].z + v[j].w * v[j].w); }
        const float rs = rsqrtf(wave_sum(s) * (1.f / D) + EPS);
        GAS v2u* o8 = (GAS v2u*)(F.XN + (size_t)m * D) + lane;
#pragma unroll
        for (int j = 0; j < 4; ++j) { const f32x4 g = gr[64 * j]; v2u o; o.x = pk2(v[j].x * rs * g.x, v[j].y * rs * g.y); o.y = pk2(v[j].z * rs * g.z, v[j].w * rs * g.w); o8[64 * j] = o; }
    }
    for (int i = F.vcu * 512 + F.tid; i < 64 * 5 * 64 * 4; i += F.G * 512) {
        const int j = i & 3, l = (i >> 2) & 63, q = i >> 8, ct = q % 5, kc = q / 5;
        const int k = kc * 16 + 4 * (l >> 4) + j, c = ct * 16 + (l & 15);
        float wv = 0.f; if (c < 8) wv = F.w_rg[k * 8 + c]; else if (c < 72) wv = F.w_re[k * 64 + (c - 8)];
        F.Wrf[i] = wv * F.g_ffn[k];
    }
}

using pg8::Unit;
struct EpiProj {
    static constexpr bool PERM = true, AFTER_DRAIN = false;
    bf16 *Q, *K, *V, *U, *G;
    __device__ __forceinline__ void operator()(const f32x4 (&acc)[2][2][4][2], const Unit& u, int wr, int wc, int fr, int fq) const {
        int row0 = u.pm * 256 + wr * 64 + fr; const int pn = u.pn;
        asm volatile("" : "+v"(row0), "+v"(fq));
        if (pn < 6) {
            bf16* base = Q + (size_t)(pn >> 1) * ((size_t)M * 512); const float sc = pn < 2 ? QSCALE : 1.f;
            const int col0 = (pn & 1) * 256 + wc * 32 + 8 * fq;
#pragma unroll
            for (int ai = 0; ai < 2; ++ai)
#pragma unroll
                for (int m = 0; m < 4; ++m) { bf16* rowp = base + (size_t)(row0 + ai * 128 + m * 16) * 512 + col0;
#pragma unroll
                    for (int bj = 0; bj < 2; ++bj) { const f32x4 v0 = acc[ai][bj][m][0] * sc, v1 = acc[ai][bj][m][1] * sc; v4u w;
                        w.x = pk2(v0[0], v0[1]); w.y = pk2(v0[2], v0[3]); w.z = pk2(v1[0], v1[1]); w.w = pk2(v1[2], v1[3]);
                        *(v4u*)(rowp + bj * 128) = w; } }
        } else if (pn < 10) {
            const int col0 = (pn - 6) * 128 + wc * 32 + 8 * fq;
#pragma unroll
            for (int ai = 0; ai < 2; ++ai)
#pragma unroll
                for (int m = 0; m < 4; ++m) { bf16* rowp = U + (size_t)(row0 + ai * 128 + m * 16) * 512 + col0;
                    const f32x4 a0 = acc[ai][0][m][0], a1 = acc[ai][0][m][1], b0 = acc[ai][1][m][0], b1 = acc[ai][1][m][1]; v4u w;
                    w.x = pk2(a0[0] * sigmoidf_(b0[0]), a0[1] * sigmoidf_(b0[1])); w.y = pk2(a0[2] * sigmoidf_(b0[2]), a0[3] * sigmoidf_(b0[3]));
                    w.z = pk2(a1[0] * sigmoidf_(b1[0]), a1[1] * sigmoidf_(b1[1])); w.w = pk2(a1[2] * sigmoidf_(b1[2]), a1[3] * sigmoidf_(b1[3]));
                    *(v4u*)rowp = w; }
        } else {
            const int col0 = (pn - 10) * 256 + wc * 32 + 8 * fq;
#pragma unroll
            for (int ai = 0; ai < 2; ++ai)
#pragma unroll
                for (int m = 0; m < 4; ++m) { bf16* rowp = G + (size_t)(row0 + ai * 128 + m * 16) * 2048 + col0;
#pragma unroll
                    for (int bj = 0; bj < 2; ++bj) { const f32x4 v0 = acc[ai][bj][m][0], v1 = acc[ai][bj][m][1]; v4u w;
                        w.x = pk2(sigmoidf_(v0[0]), sigmoidf_(v0[1])); w.y = pk2(sigmoidf_(v0[2]), sigmoidf_(v0[3]));
                        w.z = pk2(sigmoidf_(v1[0]), sigmoidf_(v1[1])); w.w = pk2(sigmoidf_(v1[2]), sigmoidf_(v1[3]));
                        *(v4u*)(rowp + bj * 128) = w; } }
        }
    }
};
struct EpiMerge {
    static constexpr bool PERM = true, AFTER_DRAIN = false;
    const bf16* G; const float* bpw; bf16* MG;
    __device__ __forceinline__ void operator()(const f32x4 (&acc)[2][2][4][2], const Unit& u, int wr, int wc, int fr, int fq) const {
        const bool sub = u.pm >= 64; const int pm = u.pm & 63, pn = u.pn & 3;
        int row0 = pm * 256 + wr * 64 + fr, col0 = pn * 256 + wc * 32 + 8 * fq;
        asm volatile("" : "+v"(row0), "+v"(col0));
        if (!sub) {
#pragma unroll
            for (int ai = 0; ai < 2; ++ai)
#pragma unroll
                for (int m = 0; m < 4; ++m) { const size_t rr = (size_t)(row0 + ai * 128 + m * 16); const bf16* gp = G + rr * 2048 + col0; bf16* op = MG + rr * 1024 + col0;
#pragma unroll
                    for (int bj = 0; bj < 2; ++bj) { const v4u g = *(const v4u*)(gp + bj * 128); const f32x4 v0 = acc[ai][bj][m][0], v1 = acc[ai][bj][m][1]; v4u w;
                        w.x = pk2(v0[0] * bflo(g.x), v0[1] * bfhi(g.x)); w.y = pk2(v0[2] * bflo(g.y), v0[3] * bfhi(g.y));
                        w.z = pk2(v1[0] * bflo(g.z), v1[1] * bfhi(g.z)); w.w = pk2(v1[2] * bflo(g.w), v1[3] * bfhi(g.w));
                        *(v4u*)(op + bj * 128) = w; } }
        } else {
            f32x4 bv[2][2];
#pragma unroll
            for (int bj = 0; bj < 2; ++bj) { bv[bj][0] = *(const f32x4*)(bpw + col0 + bj * 128); bv[bj][1] = *(const f32x4*)(bpw + col0 + bj * 128 + 4); }
#pragma unroll
            for (int ai = 0; ai < 2; ++ai)
#pragma unroll
                for (int m = 0; m < 4; ++m) { const size_t rr = (size_t)(row0 + ai * 128 + m * 16); const bf16* gp = G + rr * 2048 + 1024 + col0; bf16* op = MG + rr * 1024 + col0;
#pragma unroll
                    for (int bj = 0; bj < 2; ++bj) { const v4u g = *(const v4u*)(gp + bj * 128); const v4u t = *(const v4u*)(op + bj * 128);
                        const f32x4 v0 = acc[ai][bj][m][0] + bv[bj][0], v1 = acc[ai][bj][m][1] + bv[bj][1]; v4u w;
                        w.x = pk2(bflo(t.x) + v0[0] * bflo(g.x), bfhi(t.x) + v0[1] * bfhi(g.x)); w.y = pk2(bflo(t.y) + v0[2] * bflo(g.y), bfhi(t.y) + v0[3] * bfhi(g.y));
                        w.z = pk2(bflo(t.z) + v1[0] * bflo(g.z), bfhi(t.z) + v1[1] * bfhi(g.z)); w.w = pk2(bflo(t.w) + v1[2] * bflo(g.w), bfhi(t.w) + v1[3] * bfhi(g.w));
                        *(v4u*)(op + bj * 128) = w; } }
        }
    }
};
struct PairOrder {
    pg8::StaticOrder so;
    __device__ __forceinline__ bool next(int i, Unit& u) const { Unit b; if (!so.next(i >> 1, b)) return false; const int sub = i & 1; u.pm = b.pm + 64 * sub; u.pn = b.pn + 4 * sub; return true; }
    __device__ __forceinline__ void a_ready(const Unit&) const {}
    __device__ __forceinline__ void done(const Unit&) const {}
};
struct EpiX1 {
    static constexpr bool PERM = false, AFTER_DRAIN = false;
    const float* X; float* O;
    __device__ __forceinline__ void operator()(const f32x4 (&acc)[2][2][4][2], const Unit& u, int wr, int wc, int fr, int fq) const {
        int row0 = u.pm * 256 + wr * 64 + fr, col0 = u.pn * 256 + wc * 32 + 4 * fq;
        asm volatile("" : "+v"(row0), "+v"(col0));
#pragma unroll
        for (int ai = 0; ai < 2; ++ai)
#pragma unroll
            for (int m = 0; m < 4; ++m) { const size_t off = (size_t)(row0 + ai * 128 + m * 16) * D + col0;
#pragma unroll
                for (int bj = 0; bj < 2; ++bj)
#pragma unroll
                    for (int n = 0; n < 2; ++n) { const f32x4 xv = *(const f32x4*)(X + off + bj * 128 + n * 16); *(f32x4*)(O + off + bj * 128 + n * 16) = xv + acc[ai][bj][m][n]; } }
    }
};
struct EpiSwiglu {
    static constexpr bool PERM = true, AFTER_DRAIN = false;
    bf16* ACT;
    __device__ __forceinline__ void operator()(const f32x4 (&acc)[2][2][4][2], const Unit& u, int wr, int wc, int fr, int fq) const {
        int row0 = u.pm * 256 + wr * 64 + fr, col0 = (u.pn & 3) * 128 + wc * 32 + 8 * fq;
        asm volatile("" : "+v"(row0), "+v"(col0));
#pragma unroll
        for (int ai = 0; ai < 2; ++ai)
#pragma unroll
            for (int m = 0; m < 4; ++m) { bf16* rowp = ACT + (size_t)(row0 + ai * 128 + m * 16) * 512 + col0;
                const f32x4 a0 = acc[ai][0][m][0], a1 = acc[ai][0][m][1], b0 = acc[ai][1][m][0], b1 = acc[ai][1][m][1]; v4u w;
                w.x = pk2(a0[0] * sigmoidf_(a0[0]) * b0[0], a0[1] * sigmoidf_(a0[1]) * b0[1]); w.y = pk2(a0[2] * sigmoidf_(a0[2]) * b0[2], a0[3] * sigmoidf_(a0[3]) * b0[3]);
                w.z = pk2(a1[0] * sigmoidf_(a1[0]) * b1[0], a1[1] * sigmoidf_(a1[1]) * b1[1]); w.w = pk2(a1[2] * sigmoidf_(a1[2]) * b1[2], a1[3] * sigmoidf_(a1[3]) * b1[3]);
                *(v4u*)rowp = w; }
    }
};
struct EpiDown {
    static constexpr bool PERM = true, AFTER_DRAIN = false;
    bf16* Y;
    __device__ __forceinline__ void operator()(const f32x4 (&acc)[2][2][4][2], const Unit& u, int wr, int wc, int fr, int fq) const {
        int row0 = u.pm * 256 + wr * 64 + fr, col0 = (u.pn & 3) * 256 + wc * 32 + 8 * fq;
        asm volatile("" : "+v"(row0), "+v"(col0));
#pragma unroll
        for (int ai = 0; ai < 2; ++ai)
#pragma unroll
            for (int m = 0; m < 4; ++m) { bf16* rowp = Y + (size_t)(row0 + ai * 128 + m * 16) * 1024 + col0;
#pragma unroll
                for (int bj = 0; bj < 2; ++bj) { const f32x4 v0 = acc[ai][bj][m][0], v1 = acc[ai][bj][m][1]; v4u w;
                    w.x = pk2(v0[0], v0[1]); w.y = pk2(v0[2], v0[3]); w.z = pk2(v1[0], v1[1]); w.w = pk2(v1[2], v1[3]);
                    *(v4u*)(rowp + bj * 128) = w; } }
    }
};
struct MoeOrder {
    const LAS int* te; int ntile, G, c;
    __device__ __forceinline__ bool next(int i, Unit& u) const { const int L = i * G + c; if (L >= ntile * 4) return false; const int mt = L >> 2; u.pm = mt; u.pn = te[mt] * 4 + (L & 3); return true; }
    __device__ __forceinline__ void a_ready(const Unit&) const {}
    __device__ __forceinline__ void done(const Unit&) const {}
};
constexpr int ROWTAB_OFF = RING_BYTES;
__device__ __forceinline__ void moe_tables(Frame& F, bool with_rows) {
    LAS int* tab = (LAS int*)(F.lds + MOE_TAB_OFF);
    __syncthreads();
    const int ntile = (int)__hip_atomic_load(F.ctl + CW_NTILE, RLX_AGENT);
    if (F.tid < MAXTILES) tab[129 + F.tid] = F.tid < ntile ? ((const int*)(F.ctl + CW_TEXP))[F.tid] : 0;
    if (F.tid == 0) tab[129 + MAXTILES] = ntile < MAXTILES ? ntile : MAXTILES;
    if (with_rows) { LAS int* rt = (LAS int*)(F.lds + ROWTAB_OFF); const int* rowtok = (const int*)(F.ctl + CW_ROWTOK);
        for (int q = F.tid; q < 4 * 256; q += 512) { const int i = q >> 8, L = i * F.G + F.vcu; if (L < ntile * 4) rt[q] = rowtok[(L >> 2) * 256 + (q & 255)]; } }
    __syncthreads();
}

__device__ __forceinline__ void conv_unit(Frame& F, int unit) {
    LAS unsigned char* lds = F.lds + RING_OFF;
    const int tid = F.tid, lane = F.lane, w = F.wave;
    const int row0 = unit * 32, b = row0 / SEQ, t0 = row0 % SEQ;
#pragma unroll 1
    for (int hb = 0; hb < 2; ++hb) {   v4u sv[4];
#pragma unroll
        for (int it = 0; it < 4; ++it) { int p = tid + (hb * 4 + it) * 512; p = p < 62 * 64 ? p : 62 * 64 - 1; const int r = p >> 6, ch = p & 63; int t = t0 - 30 + r; t = t < 0 ? 0 : t;
            sv[it] = *(const GAS v4u*)(F.U + ((size_t)b * SEQ + t) * 512 + ch * 8); }
#pragma unroll
        for (int it = 0; it < 4; ++it) { const int p = tid + (hb * 4 + it) * 512; const int r = p >> 6, ch = p & 63; const int t = t0 - 30 + r;
            if (p < 62 * 64) *(LAS v4u*)(lds + r * 1024 + ch * 16) = t >= 0 ? sv[it] : (v4u){0u, 0u, 0u, 0u}; } }
    __syncthreads();
    {
        typedef float f32x2v __attribute__((ext_vector_type(2)));
        const int cp = tid & 255, rh = tid >> 8;
        f32x2v wt[CK];
#pragma unroll
        for (int j = 0; j < CK; ++j) wt[j] = *(const GAS f32x2v*)(F.w_dw + j * 512 + 2 * cp);
        const f32x2v bias = *(const GAS f32x2v*)(F.b_dw + 2 * cp);
        f32x2v a[16];
#pragma unroll
        for (int r = 0; r < 16; ++r) a[r] = bias;
        const LAS unsigned* in = (const LAS unsigned*)lds + (rh * 16) * 256 + cp;
#pragma unroll
        for (int i = 0; i < 46; ++i) { const unsigned xw = in[i * 256]; const f32x2v xv = (f32x2v){bflo(xw), bfhi(xw)};
#pragma unroll
            for (int r = 0; r < 16; ++r) { if (i - r >= 0 && i - r < CK) a[r] += wt[i - r] * xv; } }
        LAS f32x2v* yo = (LAS f32x2v*)(lds + 63488) + (rh * 16) * 256 + cp;
#pragma unroll
        for (int r = 0; r < 16; ++r) yo[r * 256] = a[r]; }
    __syncthreads();
    {   const f32x4 g0 = *(const GAS f32x4*)(F.g_cln + lane * 8), g1 = *(const GAS f32x4*)(F.g_cln + lane * 8 + 4), b0 = *(const GAS f32x4*)(F.b_cln + lane * 8), b1 = *(const GAS f32x4*)(F.b_cln + lane * 8 + 4);
#pragma unroll
        for (int k = 0; k < 4; ++k) { const int r = w * 4 + k; const LAS f32x4* yp = (const LAS f32x4*)(lds + 63488 + r * 2048) + lane * 2;
            f32x4 v0 = yp[0], v1 = yp[1];
            const float mean = wave_sum((v0.x + v0.y) + (v0.z + v0.w) + (v1.x + v1.y) + (v1.z + v1.w)) * (1.f / 512.f);
            v0 = v0 - mean; v1 = v1 - mean;
            const float var = wave_sum((v0.x * v0.x + v0.y * v0.y) + (v0.z * v0.z + v0.w * v0.w) + (v1.x * v1.x + v1.y * v1.y) + (v1.z * v1.z + v1.w * v1.w)) * (1.f / 512.f);
            const float rs = rsqrtf(var + EPS);
            v0 = v0 * rs * g0 + b0; v1 = v1 * rs * g1 + b1;
            v4u o; o.x = pk2(v0.x * sigmoidf_(v0.x), v0.y * sigmoidf_(v0.y)); o.y = pk2(v0.z * sigmoidf_(v0.z), v0.w * sigmoidf_(v0.w));
            o.z = pk2(v1.x * sigmoidf_(v1.x), v1.y * sigmoidf_(v1.y)); o.w = pk2(v1.z * sigmoidf_(v1.z), v1.w * sigmoidf_(v1.w));
            *(GAS v4u*)(F.UC + (size_t)(row0 + r) * 512 + lane * 8) = o; } }
    __syncthreads();
}

constexpr int XP_TILES = NE * 768;
constexpr int XP_SCR_OFF = 65536;
struct XpTile { const float* src; bf16* dst; int ldn, K, k0, c0; size_t r0; };
__device__ __forceinline__ XpTile xp_tile(const Frame& F, int T) {
    XpTile t; const int e = T / 768, r = T % 768;
    if (r < 512) { const int bj = r >> 8, q = r & 255, kt = q >> 4, ct = q & 15; t.c0 = ct * 32; t.k0 = kt * 64;
        t.src = (bj ? F.w_eu : F.w_eg) + (size_t)e * 1024 * 512; t.ldn = 512; t.dst = F.Wgu_t; t.K = 1024; t.r0 = (size_t)e * 1024 + (t.c0 >> 7) * 256 + bj * 128 + (t.c0 & 127); }
    else { const int q = r - 512, kt = q >> 5, ct = q & 31; t.c0 = ct * 32; t.k0 = kt * 64;
        t.src = F.w_ed + (size_t)e * 512 * 1024; t.ldn = 1024; t.dst = F.Wd_t; t.K = 512; t.r0 = (size_t)e * 1024 + t.c0; }
    return t;
}
#define XP_ISSUE(xi_) do { const int NGW_ = F.G * NWAVES; int T_ = F.vcu * NWAVES + F.wave + ((xi_) >> 1) * NGW_; T_ = T_ < XP_TILES ? T_ : XP_TILES - 1; const XpTile t_ = xp_tile(F, T_); \
        const float* p_ = t_.src + (size_t)(t_.k0 + 32 * ((xi_) & 1) + 2 * (F.lane >> 3)) * t_.ldn + t_.c0 + (F.lane & 7) * 4; \
        xa0 = *(const GAS f32x4*)p_; xb0 = *(const GAS f32x4*)(p_ + t_.ldn); xa1 = *(const GAS f32x4*)(p_ + (size_t)16 * t_.ldn); xb1 = *(const GAS f32x4*)(p_ + (size_t)17 * t_.ldn); } while (0)
#define XP_COMMIT(xi_) do { const int NGW_ = F.G * NWAVES; int T_ = F.vcu * NWAVES + F.wave + ((xi_) >> 1) * NGW_; const bool valid_ = T_ < XP_TILES; T_ = valid_ ? T_ : XP_TILES - 1; \
        LAS unsigned* scr_ = (LAS unsigned*)(F.lds + RING_OFF + XP_SCR_OFF + F.wave * 4224); const int n4_ = (F.lane & 7) * 4, kp_ = ((xi_) & 1) * 16 + (F.lane >> 3); \
        scr_[(n4_ + 0) * 33 + kp_] = pk2(xa0.x, xb0.x); scr_[(n4_ + 1) * 33 + kp_] = pk2(xa0.y, xb0.y); scr_[(n4_ + 2) * 33 + kp_] = pk2(xa0.z, xb0.z); scr_[(n4_ + 3) * 33 + kp_] = pk2(xa0.w, xb0.w); \
        scr_[(n4_ + 0) * 33 + kp_ + 8] = pk2(xa1.x, xb1.x); scr_[(n4_ + 1) * 33 + kp_ + 8] = pk2(xa1.y, xb1.y); scr_[(n4_ + 2) * 33 + kp_ + 8] = pk2(xa1.z, xb1.z); scr_[(n4_ + 3) * 33 + kp_ + 8] = pk2(xa1.w, xb1.w); \
        if ((xi_) & 1) { const XpTile t_ = xp_tile(F, T_); LDS_WAIT(); asm volatile("" ::: "memory"); \
            _Pragma("unroll") for (int jj_ = 0; jj_ < 4; ++jj_) { const int n_ = (F.lane >> 3) + 8 * jj_, ch_ = F.lane & 7; v4u o_; \
                o_.x = scr_[n_ * 33 + ch_ * 4 + 0]; o_.y = scr_[n_ * 33 + ch_ * 4 + 1]; o_.z = scr_[n_ * 33 + ch_ * 4 + 2]; o_.w = scr_[n_ * 33 + ch_ * 4 + 3]; \
                if (valid_) *(GAS v4u*)(t_.dst + (t_.r0 + n_) * (size_t)t_.K + t_.k0 + ch_ * 8) = o_; } \
            LDS_WAIT(); asm volatile("" ::: "memory"); } } while (0)

__device__ __forceinline__ int rel_bucket_dev(int d) {
    const int n = d < 0 ? -d : d; int v;
    if (n < 8) v = n; else if (n < 12) v = 8; else if (n < 16) v = 9; else if (n < 23) v = 10; else if (n < 32) v = 11; else if (n < 46) v = 12; else if (n < 64) v = 13; else if (n < 91) v = 14; else v = 15;
    return (d < 0 ? 16 : 0) + v;
}
__device__ __forceinline__ void attn_unit(Frame& F, int b, int h, int qi, float lam, int& xi, int xsteps) {
    LAS unsigned char* lds = F.lds + RING_OFF;
    const int tid = F.tid, lane = F.lane, w = F.wave, mp = w >> 2, rg = w & 3, r32 = lane & 31, hi = lane >> 5;
    const int q0 = qi * 128, qw0 = q0 + rg * 32, qrow = qw0 + r32;
    const size_t rowb = (size_t)b * SEQ;
    const int cw = qw0 >> 6, cmax = (q0 >> 6) + 1;
    LAS bf16x8* qfl = (LAS bf16x8*)(lds + 65536 + 8 * 4224 + w * 4096) + lane;
    {   const bf16* qp = F.Qb + (rowb + qrow) * 512 + h * 128 + mp * 64 + hi * 8;
#pragma unroll
        for (int d0 = 0; d0 < 4; ++d0) qfl[d0 * 64] = *(const GAS bf16x8*)(qp + d0 * 16); }
    const bf16* kg0; const bf16* kg1; const bf16* vg0; const bf16* vg1;
    {   const int key = 8 * w + (lane >> 3), cs = lane & 7, c = cs ^ ((key >> 1) & 7);
        kg0 = F.Kb + (rowb + key) * 512 + h * 128 + c * 8; kg1 = kg0 + 64;
        const int vk = 4 * w + (lane >> 4), vc = (lane & 15) ^ ((vk & 3) << 2);
        vg0 = F.Vb + (rowb + vk) * 512 + h * 128 + vc * 8; vg1 = vg0 + (size_t)32 * 512; }
    const unsigned ldsw = (unsigned)(size_t)(lds) + (unsigned)w * 1024u;
#define ATT_GLDS(gp_, dst_) do { unsigned keep_; asm volatile("s_mov_b32 %0, m0\n\ts_mov_b32 m0, %2\n\ts_nop 0\n\tglobal_load_lds_dwordx4 %1, off\n\ts_mov_b32 m0, %0" : "=&s"(keep_) : "v"(gp_), "s"(dst_) : "memory"); } while (0)
#define ATT_DMA(j, bf) do { const size_t go_ = (size_t)(j) * 64 * 512; const unsigned b_ = (unsigned)__builtin_amdgcn_readfirstlane((int)(ldsw + (unsigned)(bf) * 32768u)); \
        ATT_GLDS(kg0 + go_, b_); ATT_GLDS(kg1 + go_, b_ + 8192u); ATT_GLDS(vg0 + go_, b_ + 16384u); ATT_GLDS(vg1 + go_, b_ + 24576u); } while (0)
    ATT_DMA(0, 1); VM_WAIT();
    __syncthreads();
    f32x4 xa0, xb0, xa1, xb1;
    f32x16 o[4];
#pragma unroll
    for (int vb = 0; vb < 4; ++vb)
#pragma unroll
        for (int r = 0; r < 16; ++r) o[vb][r] = 0.f;
    float m_run = 0.f, l_run = 0.f;
    const LAS float* btab = (const LAS float*)(F.lds + ATT_TAB_OFF) + h * 192;
    const float c15 = btab[191];
    const int kfo = r32 * 128, ksw = (r32 >> 1) & 7;
    const int vsw = (lane & 15) >> 2;
    const int vrow = (4 * hi + vsw) * 256 + 32 * ((lane >> 4) & 1) + 8 * (lane & 3);
    for (int j = 0; j <= cmax; ++j) {
        const int buf = (j + 1) & 1;
        if (j < cmax) ATT_DMA(j + 1, j & 1);
        const bool xact = XP_IN_ATTN && xi < xsteps;
        if (xact) XP_ISSUE(xi);
        if (j <= cw) {
            const LAS unsigned char* kb = lds + buf * 32768 + mp * 8192;
            const LAS unsigned char* vbp = lds + buf * 32768 + 16384;
            const bool far = (64 * j + 154 <= qw0);
            f32x16 p0, p1;
#pragma unroll
            for (int r = 0; r < 16; ++r) { p0[r] = 0.f; p1[r] = 0.f; }
            {   bf16x8 ka[4], kc[4], qv[4];
#pragma unroll
                for (int d0 = 0; d0 < 4; ++d0) { const int off = kfo + (((d0 * 2 + hi) ^ ksw) << 4);
                    ka[d0] = *(const LAS bf16x8*)(kb + off); kc[d0] = *(const LAS bf16x8*)(kb + off + 4096); qv[d0] = qfl[d0 * 64]; }
#pragma unroll
                for (int d0 = 0; d0 < 4; ++d0) {
                    p0 = __builtin_amdgcn_mfma_f32_32x32x16_bf16(ka[d0], qv[d0], p0, 0, 0, 0);
                    p1 = __builtin_amdgcn_mfma_f32_32x32x16_bf16(kc[d0], qv[d0], p1, 0, 0, 0); }
#ifdef DUP_MFMA
                { bf16x8 zf = (bf16x8){0,0,0,0,0,0,0,0}; asm volatile("" : "+v"(zf));
#pragma unroll
                for (int d0 = 0; d0 < 4; ++d0) {
                    p0 = __builtin_amdgcn_mfma_f32_32x32x16_bf16(ka[d0], zf, p0, 0, 0, 0);
                    p1 = __builtin_amdgcn_mfma_f32_32x32x16_bf16(kc[d0], zf, p1, 0, 0, 0); } }
#endif
#ifdef DUP_LDSK
#pragma unroll
                for (int rep = 0; rep < DUP_LDSK; ++rep)
#pragma unroll
                for (int d0 = 0; d0 < 4; ++d0) { const int off = kfo + (((d0 * 2 + hi) ^ ksw) << 4);
                    const bf16x8 t0 = *(const volatile LAS bf16x8*)(kb + off), t1 = *(const volatile LAS bf16x8*)(kb + off + 4096), t2 = *(const volatile LAS bf16x8*)(qfl + d0 * 64); asm volatile("" :: "v"(t0), "v"(t1), "v"(t2)); }
#endif
                }
            if (!far) { const int dq = qrow - 64 * j + 63;
#pragma unroll
                for (int r = 0; r < 16; ++r) { const int kk = crow(r, hi); int i0 = dq - kk; i0 = i0 > 191 ? 191 : i0; int i1 = dq - kk - 32; i1 = i1 > 191 ? 191 : i1; p0[r] += btab[i0]; p1[r] += btab[i1]; } }
            float cc = (far ? c15 : 0.f) - m_run;
            float mx = fmaxf(p0[0], p1[0]);
#pragma unroll
            for (int r = 1; r < 16; ++r) mx = fmaxf(mx, fmaxf(p0[r], p1[r]));
            const float mxc = mx + cc;
            if (j == 0) { const float d = xhalf_max(mxc); m_run = d; cc -= d; }
            else if (__any(mxc > 8.f)) { const float d = fmaxf(xhalf_max(mxc), 0.f); m_run += d; cc -= d; const float alpha = __builtin_amdgcn_exp2f(-d); l_run *= alpha;
#pragma unroll
                for (int vb = 0; vb < 4; ++vb)
#pragma unroll
                    for (int r = 0; r < 16; ++r) o[vb][r] *= alpha; }
            p0 = p0 + cc; p1 = p1 + cc;
#pragma unroll
            for (int r = 0; r < 16; ++r) { p0[r] = __builtin_amdgcn_exp2f(p0[r]); p1[r] = __builtin_amdgcn_exp2f(p1[r]); }
            {   const f32x16 ps = p0 + p1; const float s01 = (ps[0] + ps[1]) + (ps[2] + ps[3]), s23 = (ps[4] + ps[5]) + (ps[6] + ps[7]), s45 = (ps[8] + ps[9]) + (ps[10] + ps[11]), s67 = (ps[12] + ps[13]) + (ps[14] + ps[15]);
                l_run += (s01 + s23) + (s45 + s67); }
            bf16x8 pf[4];
            {   v4u t;
                t.x = pk2(p0[0], p0[1]); t.y = pk2(p0[2], p0[3]); t.z = pk2(p0[4], p0[5]); t.w = pk2(p0[6], p0[7]); pf[0] = __builtin_bit_cast(bf16x8, t);
                t.x = pk2(p0[8], p0[9]); t.y = pk2(p0[10], p0[11]); t.z = pk2(p0[12], p0[13]); t.w = pk2(p0[14], p0[15]); pf[1] = __builtin_bit_cast(bf16x8, t);
                t.x = pk2(p1[0], p1[1]); t.y = pk2(p1[2], p1[3]); t.z = pk2(p1[4], p1[5]); t.w = pk2(p1[6], p1[7]); pf[2] = __builtin_bit_cast(bf16x8, t);
                t.x = pk2(p1[8], p1[9]); t.y = pk2(p1[10], p1[11]); t.z = pk2(p1[12], p1[13]); t.w = pk2(p1[14], p1[15]); pf[3] = __builtin_bit_cast(bf16x8, t); }
            {   s16x4 vl[2][4], vh[2][4];
#define ATT_VRD(vb_, set_) do { const LAS unsigned char* vp_ = vbp + vrow + (((vb_) ^ vsw) << 6); _Pragma("unroll") for (int ks_ = 0; ks_ < 4; ++ks_) { \
                    vl[set_][ks_] = __builtin_bit_cast(s16x4, __builtin_amdgcn_ds_read_tr16_b64_v4i16((LAS s16x4*)(vp_ + ks_ * 4096))); \
                    vh[set_][ks_] = __builtin_bit_cast(s16x4, __builtin_amdgcn_ds_read_tr16_b64_v4i16((LAS s16x4*)(vp_ + ks_ * 4096 + 2048))); } } while (0)
#define ATT_PV(vb_, set_) do { _Pragma("unroll") for (int ks_ = 0; ks_ < 4; ++ks_) { const s16x4 lo_ = vl[set_][ks_], hh_ = vh[set_][ks_]; \
                    const bf16x8 va_ = (bf16x8){lo_[0], lo_[1], lo_[2], lo_[3], hh_[0], hh_[1], hh_[2], hh_[3]}; o[vb_] = __builtin_amdgcn_mfma_f32_32x32x16_bf16(va_, pf[ks_], o[vb_], 0, 0, 0); } } while (0)
                ATT_VRD(0, 0); ATT_VRD(1, 1); ATT_PV(0, 0); ATT_VRD(2, 0); ATT_PV(1, 1); ATT_VRD(3, 1); ATT_PV(2, 0); ATT_PV(3, 1);
#undef ATT_VRD
#undef ATT_PV
            }
        }
        if (xact) { XP_COMMIT(xi); ++xi; }
        VM_WAIT();
        __syncthreads();
    }
#undef ATT_DMA
#undef ATT_GLDS
    const float inv = 1.f / xhalf_sum(l_run);
    LAS unsigned* X = (LAS unsigned*)lds + rg * 2048 + lane;
    if (mp == 1) {
#pragma unroll
        for (int vb = 0; vb < 4; ++vb)
#pragma unroll
            for (int r2 = 0; r2 < 8; ++r2) X[(vb * 8 + r2) * 64] = pk2(o[vb][2 * r2] * inv, o[vb][2 * r2 + 1] * inv); }
    __syncthreads();
    if (mp == 0) {
        float ss = 0.f;
#pragma unroll
        for (int vb = 0; vb < 4; ++vb)
#pragma unroll
            for (int r2 = 0; r2 < 8; ++r2) { const unsigned xw = X[(vb * 8 + r2) * 64];
                const float v0 = o[vb][2 * r2] * inv - lam * bflo(xw), v1 = o[vb][2 * r2 + 1] * inv - lam * bfhi(xw); o[vb][2 * r2] = v0; o[vb][2 * r2 + 1] = v1; ss += v0 * v0 + v1 * v1; }
        ss = xhalf_sum(ss);
        const float rs = rsqrtf(ss * (1.f / 128.f) + EPS) * 0.8f;
        int hi2 = hi; asm volatile("" : "+v"(hi2));
        bf16* op = F.AO + (rowb + qrow) * 512 + h * 128;
#pragma unroll
        for (int vb = 0; vb < 4; ++vb)
#pragma unroll
            for (int rq = 0; rq < 4; ++rq) { const int v0 = vb * 32 + 8 * rq + 4 * hi2; const f32x4 g = *(const GAS f32x4*)(F.gsub + v0); v2u ow;
                ow.x = pk2(o[vb][4 * rq + 0] * rs * g.x, o[vb][4 * rq + 1] * rs * g.y); ow.y = pk2(o[vb][4 * rq + 2] * rs * g.z, o[vb][4 * rq + 3] * rs * g.w);
                *(GAS v2u*)(op + v0) = ow; }
    }
}
__device__ __forceinline__ void p2_mixers(Frame& F) {
#ifdef DBG_NO_CONV
    for (size_t i = (size_t)blockIdx.x * 512 + F.tid; i < (size_t)M * 512 * 2 / 16; i += (size_t)F.G * 512) ((GAS v4u*)F.UC)[i] = (v4u){0u, 0u, 0u, 0u};
#else
#ifdef REP_CONV
    for (int rep = 0; rep < 2; ++rep)
#endif
    for (int u = F.vcu; u < M / 32; u += F.G) conv_unit(F, u);
#endif
    {   LAS float* bt = (LAS float*)(F.lds + ATT_TAB_OFF);
        for (int i = F.tid; i < NH * 192; i += 512) { const int h = i / 192, d = i % 192 - 63; bt[i] = F.relb[rel_bucket_dev(d) * NH + h] * LOG2E; } }
    int xi = 0; const int xsteps = 2 * ((XP_TILES + F.G * NWAVES - 1) / (F.G * NWAVES));
    float lam;
    {   const float a = wave_sum(F.lq1[F.lane] * F.lk1[F.lane]), c = wave_sum(F.lq2[F.lane] * F.lk2[F.lane]); lam = __expf(a) - __expf(c) + 0.2f; }
    __syncthreads();
#ifdef DBG_NO_ATT
    for (size_t i = (size_t)blockIdx.x * 512 + F.tid; i < (size_t)M * 512 * 2 / 16; i += (size_t)F.G * 512) ((GAS v4u*)F.AO)[i] = (v4u){0u, 0u, 0u, 0u};
    if (lam == 123.f) F.AO[0] = 1;
#else
#ifdef REP_ATT
    for (int rep = 0; rep < 2; ++rep)
#endif
    for (int v = F.vcu; v < 256; v += F.G) { const int bh = v >> 4, s = v & 15;
#pragma unroll 1
        for (int k = 0; k < 2; ++k) attn_unit(F, bh >> 2, bh & 3, k ? 31 - s : s, lam, xi, xsteps); }
#endif
    __syncthreads();
    if (XP_IN_ATTN) { f32x4 xa0, xb0, xa1, xb1; while (xi < xsteps) { XP_ISSUE(xi); XP_COMMIT(xi); ++xi; } }
    __syncthreads();
}

typedef float f32x4v __attribute__((ext_vector_type(4)));
__device__ __forceinline__ void p5a_router(Frame& F, bool dry) {
    LAS unsigned char* lds = F.lds + RING_OFF;
    LAS float* LP = (LAS float*)lds;
    LAS float* SS = (LAS float*)(lds + 40960);
    LAS int* lcnt = (LAS int*)(lds + 40960 + 1024);
    LAS int* lbase = (LAS int*)(lds + 40960 + 2048);
    const int tid = F.tid, lane = F.lane, w = F.wave, rt = w & 3, kh = w >> 2, r16 = lane & 15, kq = lane >> 4;
    for (int blk = F.vcu; blk < M / 64; blk += F.G) {
        if (tid < 64) lcnt[tid] = 0;
        {   const int row = blk * 64 + rt * 16 + r16;
            const float* xp = F.out + (size_t)row * D + kh * 512 + 4 * kq;
            const GAS f32x4* wf = (const GAS f32x4*)F.Wrf + (size_t)(kh * 32) * 5 * 64 + lane;
            f32x4 acc[5]; float ss = 0.f;
#pragma unroll
            for (int ct = 0; ct < 5; ++ct) acc[ct] = (f32x4){0.f, 0.f, 0.f, 0.f};
#pragma unroll 4
            for (int kc = 0; kc < 32; ++kc) {
                const f32x4 a = *(const GAS f32x4*)(xp + kc * 16);
                f32x4 bw[5];
#pragma unroll
                for (int ct = 0; ct < 5; ++ct) bw[ct] = wf[(kc * 5 + ct) * 64];
                ss += (a.x * a.x + a.y * a.y) + (a.z * a.z + a.w * a.w);
#pragma unroll
                for (int ct = 0; ct < 5; ++ct) {
                    acc[ct] = __builtin_amdgcn_mfma_f32_16x16x4f32(a.x, bw[ct].x, acc[ct], 0, 0, 0);
                    acc[ct] = __builtin_amdgcn_mfma_f32_16x16x4f32(a.y, bw[ct].y, acc[ct], 0, 0, 0);
                    acc[ct] = __builtin_amdgcn_mfma_f32_16x16x4f32(a.z, bw[ct].z, acc[ct], 0, 0, 0);
                    acc[ct] = __builtin_amdgcn_mfma_f32_16x16x4f32(a.w, bw[ct].w, acc[ct], 0, 0, 0); }
            }
            ss += __shfl_xor(ss, 16); ss += __shfl_xor(ss, 32);
            if (kq == 0) SS[kh * 64 + rt * 16 + r16] = ss;
#pragma unroll
            for (int ct = 0; ct < 5; ++ct)
#pragma unroll
                for (int rg = 0; rg < 4; ++rg) LP[(kh * 64 + rt * 16 + 4 * kq + rg) * 80 + ct * 16 + r16] = acc[ct][rg];
        }
        __syncthreads();
        int e0 = 0, e1 = 0, rk0 = 0, rk1 = 0; float w0 = 0.f, w1 = 0.f, rstd = 0.f;
        if (tid < 64) {
            const int r = tid; const LAS float* l0 = LP + r * 80; const LAS float* l1 = LP + (64 + r) * 80;
            rstd = rsqrtf((SS[r] + SS[64 + r]) * (1.f / D) + EPS);
            float lg[8]; int grp = 0; float mx = -3.0e38f;
#pragma unroll
            for (int g = 0; g < 8; ++g) { lg[g] = (l0[g] + l1[g]) * rstd + F.b_rg[g]; if (lg[g] > mx) { mx = lg[g]; grp = g; } }
            float den = 0.f;
#pragma unroll
            for (int g = 0; g < 8; ++g) den += __expf(lg[g] - mx);
            const float pg = 1.f / den;
            float v0 = -3.0e38f, v1 = -3.0e38f; int j0 = 0, j1 = 0;
            for (int j = 0; j < 8; ++j) { const float le = (l0[8 + grp * 8 + j] + l1[8 + grp * 8 + j]) * rstd + F.b_re[grp * 8 + j];
                if (le > v0) { v1 = v0; j1 = j0; v0 = le; j0 = j; } else if (le > v1) { v1 = le; j1 = j; } }
            w0 = pg / (1.f + __expf(v1 - v0)); w1 = pg - w0;
            e0 = grp * 8 + j0; e1 = grp * 8 + j1;
            rk0 = __hip_atomic_fetch_add(lcnt + e0, 1, __ATOMIC_RELAXED, __HIP_MEMORY_SCOPE_WORKGROUP);
            rk1 = __hip_atomic_fetch_add(lcnt + e1, 1, __ATOMIC_RELAXED, __HIP_MEMORY_SCOPE_WORKGROUP);
        }
        __syncthreads();
        if (tid < 64) { const int c = lcnt[tid]; int base = 0, p0 = 0, p1 = 0;
            if (c > 0) { base = (int)__hip_atomic_fetch_add(F.ctl + CW_GCNT + 64 * tid, (unsigned)c, RLX_AGENT);
                const int vt0 = base >> 8, vt1 = (base + c - 1) >> 8;
#pragma unroll 1
                for (int k = 0; k < 2; ++k) { const int vt = k ? vt1 : vt0; int ph;
                    if (k && vt1 == vt0) ph = p0;
                    else { gu32* wd = F.ctl + CW_TMAP + 64 * tid + vt; unsigned v = __hip_atomic_load(wd, RLX_AGENT);
                        if (v == 0u) { unsigned expect = 0u;
                            if (__hip_atomic_compare_exchange_strong(wd, &expect, 0xFFFFFFFFu, __ATOMIC_RELAXED, __ATOMIC_RELAXED, __HIP_MEMORY_SCOPE_AGENT)) {
                                const unsigned p = __hip_atomic_fetch_add(F.ctl + CW_NTILE, 1u, RLX_AGENT); ((int*)(F.ctl + CW_TEXP))[p < 255u ? p : 255u] = tid; v = p + 1u; __hip_atomic_store(wd, v, RLX_AGENT); }
                            else v = expect; }
                        for (unsigned sp = 0; v == 0xFFFFFFFFu && sp < (1u << 20); ++sp) { __builtin_amdgcn_s_sleep(1); v = __hip_atomic_load(wd, RLX_AGENT); }
                        ph = (int)v - 1; }
                    if (k) p1 = ph; else p0 = ph; } }
            lbase[tid] = base; lbase[64 + 2 * tid] = p0; lbase[64 + 2 * tid + 1] = p1; }
        __syncthreads();
        if (tid < 64) { const int t = blk * 64 + tid; int* rowtok = (int*)(F.ctl + CW_ROWTOK);
            const int b0 = lbase[e0], pos0 = b0 + rk0, s0 = ((pos0 >> 8) == (b0 >> 8) ? lbase[64 + 2 * e0] : lbase[64 + 2 * e0 + 1]) * 256 + (pos0 & 255);
            const int b1 = lbase[e1], pos1 = b1 + rk1, s1 = ((pos1 >> 8) == (b1 >> 8) ? lbase[64 + 2 * e1] : lbase[64 + 2 * e1 + 1]) * 256 + (pos1 & 255);
            F.tokslot[2 * t] = s0; F.tokslot[2 * t + 1] = s1; F.roww[2 * t] = w0; F.roww[2 * t + 1] = w1; rowtok[s0] = t; rowtok[s1] = t;
            SS[128 + tid] = rstd; }
        __syncthreads();
        for (int k = 0; k < 8; k += 2) {
            f32x4 xa[2][2][2]; float rsd[2];
#pragma unroll
            for (int q = 0; q < 2; ++q) { const int r = w * 8 + k + q, t = blk * 64 + r; rsd[q] = SS[128 + r]; const float* xr = F.out + (size_t)t * D;
#pragma unroll
                for (int hf = 0; hf < 2; ++hf) { const int c = hf * 512 + lane * 8; xa[q][hf][0] = *(const GAS f32x4*)(xr + c); xa[q][hf][1] = *(const GAS f32x4*)(xr + c + 4); } }
#pragma unroll
            for (int hf = 0; hf < 2; ++hf) { const int c = hf * 512 + lane * 8; const f32x4 ga = *(const GAS f32x4*)(F.g_ffn + c), gb = *(const GAS f32x4*)(F.g_ffn + c + 4);
#pragma unroll
                for (int q = 0; q < 2; ++q) { const int t = blk * 64 + w * 8 + k + q; const f32x4 a = xa[q][hf][0] * rsd[q] * ga, b = xa[q][hf][1] * rsd[q] * gb; v4u o;
                    o.x = pk2(a.x, a.y); o.y = pk2(a.z, a.w); o.z = pk2(b.x, b.y); o.w = pk2(b.z, b.w);
                    *(GAS v4u*)(F.XH + (size_t)t * D + c) = o; } } }
        __syncthreads();
    }
}
__device__ __forceinline__ void p8_final(Frame& F, float* dstbase) {
    const int gw = F.vcu * NWAVES + F.wave, NGW = F.G * NWAVES, lane = F.lane;
    const GAS f32x4* gr = (const GAS f32x4*)F.g_fin + lane;
    for (int m0 = gw; m0 < M; m0 += 2 * NGW) {
        const int m1 = m0 + NGW < M ? m0 + NGW : m0;
        const int sa0 = F.tokslot[2 * m0], sa1 = F.tokslot[2 * m0 + 1], sb0 = F.tokslot[2 * m1], sb1 = F.tokslot[2 * m1 + 1];
        const float wa0 = F.roww[2 * m0], wa1 = F.roww[2 * m0 + 1], wb0 = F.roww[2 * m1], wb1 = F.roww[2 * m1 + 1];
        const GAS f32x4* xa = (const GAS f32x4*)(F.out + (size_t)m0 * D) + lane; const GAS f32x4* xb = (const GAS f32x4*)(F.out + (size_t)m1 * D) + lane;
        const GAS v2u* ya0 = (const GAS v2u*)(F.Y + (size_t)sa0 * D) + lane; const GAS v2u* ya1 = (const GAS v2u*)(F.Y + (size_t)sa1 * D) + lane;
        const GAS v2u* yb0 = (const GAS v2u*)(F.Y + (size_t)sb0 * D) + lane; const GAS v2u* yb1 = (const GAS v2u*)(F.Y + (size_t)sb1 * D) + lane;
        f32x4 va[4], vb[4]; v2u pa[4], qa[4], pb[4], qb[4];
#pragma unroll
        for (int j = 0; j < 4; ++j) { va[j] = xa[64 * j]; pa[j] = ya0[64 * j]; qa[j] = ya1[64 * j]; vb[j] = xb[64 * j]; pb[j] = yb0[64 * j]; qb[j] = yb1[64 * j]; }
        float s0 = 0.f, s1 = 0.f;
#pragma unroll
        for (int j = 0; j < 4; ++j) {
            va[j].x += wa0 * bflo(pa[j].x) + wa1 * bflo(qa[j].x); va[j].y += wa0 * bfhi(pa[j].x) + wa1 * bfhi(qa[j].x); va[j].z += wa0 * bflo(pa[j].y) + wa1 * bflo(qa[j].y); va[j].w += wa0 * bfhi(pa[j].y) + wa1 * bfhi(qa[j].y);
            vb[j].x += wb0 * bflo(pb[j].x) + wb1 * bflo(qb[j].x); vb[j].y += wb0 * bfhi(pb[j].x) + wb1 * bfhi(qb[j].x); vb[j].z += wb0 * bflo(pb[j].y) + wb1 * bflo(qb[j].y); vb[j].w += wb0 * bfhi(pb[j].y) + wb1 * bfhi(qb[j].y);
            s0 += (va[j].x * va[j].x + va[j].y * va[j].y) + (va[j].z * va[j].z + va[j].w * va[j].w);
            s1 += (vb[j].x * vb[j].x + vb[j].y * vb[j].y) + (vb[j].z * vb[j].z + vb[j].w * vb[j].w); }
        const float r0 = rsqrtf(wave_sum(s0) * (1.f / D) + EPS), r1 = rsqrtf(wave_sum(s1) * (1.f / D) + EPS);
        GAS f32x4* oa = (GAS f32x4*)(dstbase + (size_t)m0 * D) + lane; GAS f32x4* ob = (GAS f32x4*)(dstbase + (size_t)m1 * D) + lane;
#pragma unroll
        for (int j = 0; j < 4; ++j) { const f32x4 g = gr[64 * j];
            oa[64 * j] = (f32x4){va[j].x * r0 * g.x, va[j].y * r0 * g.y, va[j].z * r0 * g.z, va[j].w * r0 * g.w};
            if (m1 != m0) ob[64 * j] = (f32x4){vb[j].x * r1 * g.x, vb[j].y * r1 * g.y, vb[j].z * r1 * g.z, vb[j].w * r1 * g.w}; }
    }
}

struct Args { const float* in[26]; float* out; unsigned char* ws; int ph_lo, ph_hi; };
__global__ void __launch_bounds__(NWAVES * 64, 2) fwd_kernel(Args args) {
    extern __shared__ __attribute__((aligned(16))) unsigned char lds[];
    Frame F;
    F.lds = (LAS unsigned char*)lds;
    F.tid = threadIdx.x; F.lane = F.tid & 63; F.wave = __builtin_amdgcn_readfirstlane(F.tid >> 6);
    F.G = gridDim.x; { const int bx = blockIdx.x; F.vcu = (F.G % 8 == 0) ? (bx % 8) * (F.G / 8) + bx / 8 : bx; }
    unsigned char* ws = args.ws;
    F.ctl = (gu32*)(ws + WS_CTL);
    F.x = args.in[0]; F.w_in = args.in[1]; F.lq1 = args.in[2]; F.lk1 = args.in[3]; F.lq2 = args.in[4]; F.lk2 = args.in[5]; F.gsub = args.in[6]; F.relb = args.in[7];
    F.w_au = args.in[8]; F.w_dw = args.in[9]; F.b_dw = args.in[10]; F.g_cln = args.in[11]; F.b_cln = args.in[12]; F.w_pw = args.in[13]; F.b_pw = args.in[14]; F.w_out = args.in[15];
    F.g_mix = args.in[16]; F.g_ffn = args.in[17]; F.w_rg = args.in[18]; F.b_rg = args.in[19]; F.w_re = args.in[20]; F.b_re = args.in[21]; F.w_eg = args.in[22]; F.w_eu = args.in[23]; F.w_ed = args.in[24]; F.g_fin = args.in[25];
    F.out = args.out;
    F.Win_t = (bf16*)(ws + WS_WIN); F.Wmix_t = (bf16*)(ws + WS_WMIX); F.Wout_t = (bf16*)(ws + WS_WOUT); F.Wgu_t = (bf16*)(ws + WS_WGU); F.Wd_t = (bf16*)(ws + WS_WD);
    F.XN = (bf16*)(ws + WS_XN); F.Qb = (bf16*)(ws + WS_Q); F.Kb = (bf16*)(ws + WS_K); F.Vb = (bf16*)(ws + WS_V); F.U = (bf16*)(ws + WS_U); F.Gt = (bf16*)(ws + WS_G);
    F.AO = (bf16*)(ws + WS_AO); F.UC = (bf16*)(ws + WS_UC); F.MG = (bf16*)(ws + WS_MG); F.XH = (bf16*)(ws + WS_XH); F.ACT = (bf16*)(ws + WS_ACT); F.Y = (bf16*)(ws + WS_Y);
    F.T = (float*)(ws + WS_T); F.Wrf = (float*)(ws + WS_WRF); F.roww = (float*)(ws + WS_ROWW); F.tokinfo = (int*)(ws + WS_TOKINFO); F.tokslot = (int*)(ws + WS_TOKSLOT);
    for (int u = F.tid; u < 128; u += NWAVES * 64) ((LAS unsigned*)(F.lds + LDSCTL_OFF))[u] = 0u;
    __syncthreads();
    const int lo = args.ph_lo, hi = args.ph_hi;
    XcdBarrier bar; bar.bar = (unsigned*)(F.ctl + CW_BAR); bar.x = 0; bar.st = nullptr;
    if (hi - lo > 1) bar = xcd_barrier_post((unsigned*)(F.ctl + CW_BAR), (volatile LAS unsigned*)(F.lds + LDSCTL_OFF) + 8);
#ifndef PH_MASK
#define PH_MASK 0x3ff
#endif
#define IN(k) (((PH_MASK >> (k)) & 1) && lo <= (k) && (k) < hi)
#ifdef REP_BAR
#define SEAM(k) do { if (IN(k) && IN((k) + 1)) { xcd_barrier(bar); xcd_barrier(bar); } } while (0)
#else
#define SEAM(k) do { if (IN(k) && IN((k) + 1)) xcd_barrier(bar); } while (0)
#endif
    constexpr bool AL = true, SP = true;
#ifndef REP_MASK
#define REP_MASK 0
#endif
#define REPS(k) ((((REP_MASK) >> (k)) & 1) ? 2 : 1)

    if (IN(0)) { for (int rep = 0; rep < REPS(0); ++rep) { p0_prologue(F); if (rep + 1 < REPS(0)) __syncthreads(); } SEAM(0); }
    if (IN(1)) { for (int rep = 0; rep < REPS(1); ++rep) {
        pg8::Gemm g{F.XN, F.Win_t, M, NCOL, D}; pg8::StaticOrder S; S.init(M, NCOL, F.G, (int)blockIdx.x);
        EpiProj E{F.Qb, F.Kb, F.Vb, F.U, F.Gt};
        pg8::gemm_phase<EpiProj, pg8::StaticOrder, AL, SP>(F.lds + RING_OFF, g, S, E); }
        SEAM(1);
    }
#if defined(DBG_ZERO_P2)
    if (IN(2)) { for (size_t i = (size_t)blockIdx.x * 512 + F.tid; i < (size_t)M * 1024 * 2 / 16; i += (size_t)F.G * 512) ((GAS v4u*)F.AO)[i] = ((const GAS v4u*)F.XN)[i]; SEAM(2); }
#else
    if (IN(2)) { for (int rep = 0; rep < REPS(2); ++rep) p2_mixers(F); SEAM(2); }
#endif
    if (IN(3)) { for (int rep = 0; rep < REPS(3); ++rep) {
        pg8::Gemm g{F.AO, F.Wmix_t, 2 * M, 2048, 512}; PairOrder S; S.so.init(M, 1024, F.G, (int)blockIdx.x);
        EpiMerge E{F.Gt, F.b_pw, F.MG};
        pg8::gemm_phase<EpiMerge, PairOrder, AL, SP>(F.lds + RING_OFF, g, S, E); }
        SEAM(3);
    }
    if (IN(4)) { for (int rep = 0; rep < REPS(4); ++rep) {
        pg8::Gemm g{F.MG, F.Wout_t, M, D, D}; pg8::StaticOrder S; S.init(M, D, F.G, (int)blockIdx.x);
        EpiX1 E{F.x, F.out};
        pg8::gemm_phase<EpiX1, pg8::StaticOrder, AL, SP>(F.lds + RING_OFF, g, S, E); }
        SEAM(4);
    }
#ifdef REP_P5A
    if (IN(5)) { p5a_router(F, true); __syncthreads(); }
#endif
    if (IN(5)) { p5a_router(F, false); if (IN(5) && IN(7)) xcd_barrier(bar); }
    if (IN(7)) { for (int rep = 0; rep < REPS(7); ++rep) {
        moe_tables(F, true);
        const LAS int* tab = (const LAS int*)(F.lds + MOE_TAB_OFF);
        pg8::Gemm g{F.XH, F.Wgu_t, M, NE * 1024, D}; MoeOrder S{tab + 129, tab[129 + MAXTILES], F.G, F.vcu};
        EpiSwiglu E{F.ACT};
        pg8::gemm_phase_g<EpiSwiglu, MoeOrder, AL>(F.lds + RING_OFF, g, (const LAS int*)(F.lds + ROWTAB_OFF), S, E); }
        SEAM(7);
    }
    if (IN(8)) { for (int rep = 0; rep < REPS(8); ++rep) {
        moe_tables(F, false);
        const LAS int* tab = (const LAS int*)(F.lds + MOE_TAB_OFF);
        pg8::Gemm g{F.ACT, F.Wd_t, MAXTILES * 256, NE * 1024, DE}; MoeOrder S{tab + 129, tab[129 + MAXTILES], F.G, F.vcu};
        EpiDown E{F.Y};
        pg8::gemm_phase<EpiDown, MoeOrder, AL, SP>(F.lds + RING_OFF, g, S, E); }
        SEAM(8);
    }
#ifdef REP_P9
    if (IN(9)) { p8_final(F, (float*)F.XH); __syncthreads(); }
#endif
    if (IN(9)) { p8_final(F, F.out); }
#undef IN
#undef SEAM
}

#ifndef MK_N_LAUNCHES
#define MK_N_LAUNCHES 1
#endif
extern "C" void kernel_launch(void* const* d_in, const int* in_sizes, int n_in, void* d_out, int out_size, void* d_ws, size_t ws_size, hipStream_t stream) {
    static int grid = 0;
    if (grid == 0) {
        if (n_in != 26 || in_sizes[0] != M * D || out_size != M * D || ws_size < WS_END) { fprintf(stderr, "kernel_launch: unexpected shapes (n_in %d, in0 %d, out %d, ws %zu < %zu)\n", n_in, n_in > 0 ? in_sizes[0] : -1, out_size, ws_size, (size_t)WS_END); grid = -1; return; }
        int dev = 0, cus = 0, per_cu = 0;
        if (hipGetDevice(&dev) != hipSuccess || hipDeviceGetAttribute(&cus, hipDeviceAttributeMultiprocessorCount, dev) != hipSuccess) { grid = -1; return; }
        if (hipFuncSetAttribute((const void*)fwd_kernel, hipFuncAttributeMaxDynamicSharedMemorySize, LDS_BYTES) != hipSuccess) { fprintf(stderr, "kernel_launch: hipFuncSetAttribute failed\n"); grid = -1; return; }
        if (hipOccupancyMaxActiveBlocksPerMultiprocessor(&per_cu, (const void*)fwd_kernel, NWAVES * 64, LDS_BYTES) != hipSuccess || per_cu < 1)
            fprintf(stderr, "kernel_launch: occupancy query reports %d workgroups per CU\n", per_cu);
        (void)hipGetLastError();
        grid = cus;
    }
    if (grid < 0) return;
    if (hipMemsetAsync((char*)d_ws + WS_CTL, 0, CTL_ZERO_BYTES, stream) != hipSuccess) return;
    Args a{};
    for (int i = 0; i < 26; ++i) a.in[i] = (const float*)d_in[i];
    a.out = (float*)d_out; a.ws = (unsigned char*)d_ws;
#if MK_N_LAUNCHES == 1
    a.ph_lo = 0; a.ph_hi = NPHASE;
    hipLaunchKernelGGL(fwd_kernel, dim3(grid), dim3(NWAVES * 64), LDS_BYTES, stream, a);
#else
    for (int p = 0; p < NPHASE; ++p) { a.ph_lo = p; a.ph_hi = p + 1; hipLaunchKernelGGL(fwd_kernel, dim3(grid), dim3(NWAVES * 64), LDS_BYTES, stream, a); }
#endif
}
```
